# Optimizing an MI355X kernel written in HIP

```python
import jax
import jax.numpy as jnp
from jax import lax
import numpy as np

D_MODEL = 1024
BATCH = 8
SEQ = 2048
DEPTH = 1

RET_HEADS = 4
RET_DK = 128
RET_DV = 256
GLA_HEADS = 4
GLA_DK = 128
GLA_DV = 256
GLA_GATE_RANK = 16
GLA_GATE_NORMALIZER = 16.0
CHUNK = 128
N_BRANCHES = 2
N_EXPERTS = 16
EC_CAPACITY_FACTOR = 2
D_FF = 2816
ROPE_THETA = 10000.0
NORM_EPS = 1e-6

RET_QK = RET_HEADS * RET_DK
RET_V = RET_HEADS * RET_DV
GLA_QK = GLA_HEADS * GLA_DK
GLA_V = GLA_HEADS * GLA_DV
IN_SPLITS = (RET_QK, RET_QK, RET_V, RET_V,
             GLA_QK, GLA_QK, GLA_V, GLA_V, 2 * GLA_GATE_RANK,
             N_BRANCHES * D_MODEL)
D_IN = sum(IN_SPLITS)

kernel_name = 'hybrid_retention_gla_ec_moe_encoder'


def _rmsnorm(x, gain):
    xf = x.astype(jnp.float32)
    y = xf * lax.rsqrt(jnp.mean(xf * xf, axis=-1, keepdims=True) + NORM_EPS)
    return (y * gain.astype(jnp.float32)).astype(x.dtype)


def _rope(t, positions):
    d = t.shape[-1]
    inv_freq = ROPE_THETA ** (-jnp.arange(0, d, 2, dtype=jnp.float32) / d)
    ang = positions.astype(jnp.float32)[..., None] * inv_freq
    cos = jnp.cos(ang)[:, :, None, :]
    sin = jnp.sin(ang)[:, :, None, :]
    t1, t2 = t[..., : d // 2], t[..., d // 2:]
    return jnp.concatenate([t1 * cos - t2 * sin, t2 * cos + t1 * sin], axis=-1)


def _to_chunks(t):
    b, s, h, d = t.shape
    return t.reshape(b, s // CHUNK, CHUNK, h, d).transpose(0, 3, 1, 2, 4)


def _from_chunks(t):
    b, h, n, c, d = t.shape
    return t.transpose(0, 2, 3, 1, 4).reshape(b, n * c, h, d)


def _flip(t):
    return jnp.flip(t, axis=1)


def _causal_mask(c, strict):
    pos = jnp.arange(c)
    return pos[:, None] > pos[None, :] if strict else pos[:, None] >= pos[None, :]


def _prefix_states(decay, kv):
    def step(s, inp):
        dec, u = inp
        return dec * s + u, s
    s0 = jnp.zeros_like(kv[:, :, 0])
    _, s_prev = lax.scan(step, s0, (jnp.moveaxis(decay, 2, 0), jnp.moveaxis(kv, 2, 0)))
    return jnp.moveaxis(s_prev, 0, 2)


def _retention_scan(q, k, v, log_gamma, strict):
    b, h, n, c, _ = q.shape
    pos = jnp.arange(c, dtype=jnp.float32)
    rel = pos[:, None] - pos[None, :]
    mask = _causal_mask(c, strict)
    decay_mask = jnp.where(mask, jnp.exp(jnp.where(mask, rel, 0.0) * log_gamma[:, None, None]), 0.0)
    scores = jnp.einsum('bhncd,bhnsd->bhncs', q, k) * decay_mask[None, :, None]
    intra = jnp.einsum('bhncs,bhnse->bhnce', scores, v)
    k_w = k * jnp.exp((c - 1.0 - pos)[None, :] * log_gamma[:, None])[None, :, None, :, None]
    kv = jnp.einsum('bhncd,bhnce->bhnde', k_w, v)
    chunk_decay = jnp.broadcast_to(jnp.exp(c * log_gamma)[None, :, None, None, None], (b, h, n, 1, 1))
    s_prev = _prefix_states(chunk_decay, kv)
    q_w = q * jnp.exp((pos + 1.0)[None, :] * log_gamma[:, None])[None, :, None, :, None]
    inter = jnp.einsum('bhncd,bhnde->bhnce', q_w, s_prev)
    return intra + inter


def _gla_scan(q, k, v, log_alpha, strict):
    c = q.shape[3]
    cum = jnp.cumsum(log_alpha, axis=3)
    ref = cum[:, :, :, c // 2:c // 2 + 1]
    last = cum[:, :, :, -1:]
    scores = jnp.einsum('bhncd,bhnsd->bhncs', q * jnp.exp(cum - ref), k * jnp.exp(ref - cum))
    scores = jnp.where(_causal_mask(c, strict), scores, 0.0)
    intra = jnp.einsum('bhncs,bhnse->bhnce', scores, v)
    kv = jnp.einsum('bhncd,bhnce->bhnde', k * jnp.exp(last - cum), v)
    s_prev = _prefix_states(jnp.swapaxes(jnp.exp(last), -1, -2), kv)
    inter = jnp.einsum('bhncd,bhnde->bhnce', q * jnp.exp(cum), s_prev)
    return intra + inter


def _mixer(h, positions, w_in, ret_decay_fwd, ret_decay_bwd, ret_norm,
           gla_gate_w_fwd, gla_gate_b_fwd, gla_gate_w_bwd, gla_gate_b_bwd, gla_norm,
           w_branch_ret, w_branch_gla, w_out):
    b, s, _ = h.shape
    f32 = jnp.float32
    proj = h @ w_in
    split_at = [int(i) for i in np.cumsum(IN_SPLITS)[:-1]]
    rq, rk, rv, rg, gq, gk, gv, gr, ga, gate_logits = jnp.split(proj, split_at, axis=-1)

    rq = _rope(rq.astype(f32).reshape(b, s, RET_HEADS, RET_DK), positions) * RET_DK ** -0.5
    rk = _rope(rk.astype(f32).reshape(b, s, RET_HEADS, RET_DK), positions)
    rv = rv.astype(f32).reshape(b, s, RET_HEADS, RET_DV)
    lg_f = jax.nn.log_sigmoid(ret_decay_fwd.astype(f32))
    lg_b = jax.nn.log_sigmoid(ret_decay_bwd.astype(f32))
    ret = _from_chunks(_retention_scan(_to_chunks(rq), _to_chunks(rk), _to_chunks(rv), lg_f, False))
    ret = ret + _flip(_from_chunks(_retention_scan(
        _to_chunks(_flip(rq)), _to_chunks(_flip(rk)), _to_chunks(_flip(rv)), lg_b, True)))
    mu = jnp.mean(ret, axis=-1, keepdims=True)
    var = jnp.mean(jnp.square(ret - mu), axis=-1, keepdims=True)
    ret = ((ret - mu) * lax.rsqrt(var + NORM_EPS)).reshape(b, s, RET_V) * ret_norm.astype(f32)
    ret = (ret * jax.nn.silu(rg.astype(f32))).astype(h.dtype)

    gq = gq.astype(f32).reshape(b, s, GLA_HEADS, GLA_DK) * GLA_DK ** -0.5
    gk = gk.astype(f32).reshape(b, s, GLA_HEADS, GLA_DK)
    gv = gv.astype(f32).reshape(b, s, GLA_HEADS, GLA_DV)
    ga_f, ga_b = jnp.split(ga.astype(f32), 2, axis=-1)
    la_f = (jax.nn.log_sigmoid(ga_f @ gla_gate_w_fwd.astype(f32) + gla_gate_b_fwd.astype(f32))
            / GLA_GATE_NORMALIZER).reshape(b, s, GLA_HEADS, GLA_DK)
    la_b = (jax.nn.log_sigmoid(ga_b @ gla_gate_w_bwd.astype(f32) + gla_gate_b_bwd.astype(f32))
            / GLA_GATE_NORMALIZER).reshape(b, s, GLA_HEADS, GLA_DK)
    gla = _from_chunks(_gla_scan(_to_chunks(gq), _to_chunks(gk), _to_chunks(gv), _to_chunks(la_f), False))
    gla = gla + _flip(_from_chunks(_gla_scan(
        _to_chunks(_flip(gq)), _to_chunks(_flip(gk)), _to_chunks(_flip(gv)), _to_chunks(_flip(la_b)), True)))
    gla = gla * lax.rsqrt(jnp.mean(gla * gla, axis=-1, keepdims=True) + NORM_EPS)
    gla = gla.reshape(b, s, GLA_V) * gla_norm.astype(f32)
    gla = (gla * jax.nn.silu(gr.astype(f32))).astype(h.dtype)

    g_ret, g_gla = jnp.split(jax.nn.sigmoid(gate_logits.astype(f32)), N_BRANCHES, axis=-1)
    merged = g_ret * (ret @ w_branch_ret).astype(f32) + g_gla * (gla @ w_branch_gla).astype(f32)
    return merged.astype(h.dtype) @ w_out


def _expert_choice_moe(h, w_router, w_gate, w_up, w_down):
    b, s, d = h.shape
    capacity = EC_CAPACITY_FACTOR * s // N_EXPERTS
    affinity = jax.nn.softmax((h @ w_router).astype(jnp.float32), axis=-1)
    gate, idx = lax.top_k(jnp.swapaxes(affinity, 1, 2), capacity)
    xg = jax.vmap(lambda hb, ib: hb[ib])(h, idx)
    act = jax.nn.silu(jnp.einsum('becd,edf->becf', xg, w_gate)) * jnp.einsum('becd,edf->becf', xg, w_up)
    y = jnp.einsum('becf,efd->becd', act, w_down) * gate[..., None].astype(h.dtype)
    return jax.vmap(lambda ib, yb: jnp.zeros((s, d), yb.dtype).at[ib.reshape(-1)].add(yb.reshape(-1, d)))(idx, y)


def setup_inputs(seed: int = 0) -> dict:
    key = jax.random.key(seed)
    ks = jax.random.split(key, 24)
    L, D = DEPTH, D_MODEL
    f32 = jnp.float32

    def dense(k, shape, fan_in):
        return jax.random.normal(k, shape, f32) * fan_in ** -0.5

    def gain(k, shape):
        return 1.0 + 0.02 * jax.random.normal(k, shape, f32)

    gamma0 = 1.0 - 2.0 ** (-5.0 - np.arange(RET_HEADS))
    logit0 = jnp.asarray(np.log(gamma0) - np.log1p(-gamma0), f32)
    return {
        'x': jax.random.normal(ks[0], (BATCH, SEQ, D), f32),
        'positions': jnp.broadcast_to(jnp.arange(SEQ, dtype=jnp.int32), (BATCH, SEQ)),
        'norm_mix': gain(ks[1], (L, D)),
        'w_in': dense(ks[2], (L, D, D_IN), D),
        'ret_decay_fwd': logit0 + 0.05 * jax.random.normal(ks[3], (L, RET_HEADS), f32),
        'ret_decay_bwd': logit0 + 0.05 * jax.random.normal(ks[4], (L, RET_HEADS), f32),
        'ret_norm': gain(ks[5], (L, RET_V)),
        'gla_gate_w_fwd': dense(ks[6], (L, GLA_GATE_RANK, GLA_QK), GLA_GATE_RANK),
        'gla_gate_b_fwd': 0.1 * jax.random.normal(ks[7], (L, GLA_QK), f32),
        'gla_gate_w_bwd': dense(ks[8], (L, GLA_GATE_RANK, GLA_QK), GLA_GATE_RANK),
        'gla_gate_b_bwd': 0.1 * jax.random.normal(ks[9], (L, GLA_QK), f32),
        'gla_norm': gain(ks[10], (L, GLA_V)),
        'w_branch_ret': dense(ks[11], (L, RET_V, D), RET_V),
        'w_branch_gla': dense(ks[12], (L, GLA_V, D), GLA_V),
        'w_out': dense(ks[13], (L, D, D), D),
        'norm_ffn': gain(ks[14], (L, D)),
        'w_router': dense(ks[15], (L, D, N_EXPERTS), D),
        'w_gate': dense(ks[16], (L, N_EXPERTS, D, D_FF), D),
        'w_up': dense(ks[17], (L, N_EXPERTS, D, D_FF), D),
        'w_down': dense(ks[18], (L, N_EXPERTS, D_FF, D), D_FF),
        'norm_final': gain(ks[19], (D,)),
    }


def reference(x, positions, norm_mix, w_in, ret_decay_fwd, ret_decay_bwd, ret_norm,
              gla_gate_w_fwd, gla_gate_b_fwd, gla_gate_w_bwd, gla_gate_b_bwd, gla_norm,
              w_branch_ret, w_branch_gla, w_out, norm_ffn, w_router, w_gate, w_up, w_down,
              norm_final):
    for l in range(DEPTH):
        h = _rmsnorm(x, norm_mix[l])
        x = x + _mixer(h, positions, w_in[l], ret_decay_fwd[l], ret_decay_bwd[l], ret_norm[l],
                       gla_gate_w_fwd[l], gla_gate_b_fwd[l], gla_gate_w_bwd[l], gla_gate_b_bwd[l],
                       gla_norm[l], w_branch_ret[l], w_branch_gla[l], w_out[l])
        h = _rmsnorm(x, norm_ffn[l])
        x = x + _expert_choice_moe(h, w_router[l], w_gate[l], w_up[l], w_down[l])
    return _rmsnorm(x, norm_final)
```

```cpp
#include <hip/hip_runtime.h>
#include <cstdio>
#include <cstdint>

#ifndef MK_N_LAUNCHES
#define MK_N_LAUNCHES 1
#endif

#ifndef MOE_FP8
#define MOE_FP8 1
#endif
#ifndef PROBE_MASK
#define PROBE_MASK 0x0
#endif
#define GAS __attribute__((address_space(1)))
#define LAS __attribute__((address_space(3)))

__device__ __forceinline__ int lane_id_now() { int l_; asm volatile("v_mbcnt_lo_u32_b32 %0, -1, 0\n\tv_mbcnt_hi_u32_b32 %0, -1, %0" : "=v"(l_)); return l_; }
namespace pg8 {
#define PG8_LAS __attribute__((address_space(3)))
typedef unsigned short bf16_t;
typedef short bf16x8 __attribute__((ext_vector_type(8)));
typedef float f32x4 __attribute__((ext_vector_type(4)));
typedef unsigned u32x4 __attribute__((ext_vector_type(4)));
typedef unsigned u32x2 __attribute__((ext_vector_type(2)));
typedef int i32x8 __attribute__((ext_vector_type(8)));
typedef int i32x4 __attribute__((ext_vector_type(4)));
constexpr int BM = 256, BK = 64, HALF = 128, HTB = HALF * BK * 2, STAGE_BYTES = 8 * HTB, NXCD = 8, WGM = 4;

__host__ __device__ __forceinline__ int lds_byte(int r, int c) { const int st = (r >> 4) * 2 + (c >> 5), rr = r & 15, cc = c & 31, ob = rr * 64 + cc * 2; return st * 1024 + (ob ^ (((ob >> 9) & 1) << 5)); }
__host__ __device__ __forceinline__ void stage_rc(int b, int& R, int& C) { const int st = b / 1024, sb = b % 1024, swz = sb ^ (((sb >> 9) & 1) << 5); R = (st >> 1) * 16 + swz / 64; C = (st & 1) * 32 + (swz % 64) / 2; }
__host__ __device__ __forceinline__ int perm32(int rho) { const int n = rho >> 4, i = rho & 15; return 8 * (i >> 2) + 4 * n + (i & 3); }

struct Unit { int pm, pn, aux; };

__device__ __forceinline__ void tile_of(int L, int nM, int nN, int& pm, int& pn) {
    const int nwg = nM * nN; int wgid = L;
    { const int q = nwg / NXCD, r = nwg % NXCD, xcd = wgid % NXCD, off = wgid / NXCD; wgid = (xcd < r ? xcd * (q + 1) : r * (q + 1) + (xcd - r) * q) + off; }
    const int nig = WGM * nN, gid = wgid / nig, fm = gid * WGM, gsz = (nM - fm) < WGM ? (nM - fm) : WGM;
    pm = fm + ((wgid % nig) % gsz); pn = (wgid % nig) / gsz;
}

__device__ __forceinline__ const char* uni(const char* p) { const unsigned long long v = (unsigned long long)p; const unsigned lo = __builtin_amdgcn_readfirstlane((unsigned)v), hi = __builtin_amdgcn_readfirstlane((unsigned)(v >> 32)); return (const char*)(((unsigned long long)hi << 32) | lo); }
__device__ __forceinline__ unsigned cvt_pk_bf16(float lo, float hi) { unsigned r; asm volatile("v_cvt_pk_bf16_f32 %0, %1, %2" : "=v"(r) : "v"(lo), "v"(hi)); return r; }

template <int K, class Epi, class Sched, bool ALIGN_EPI, bool SP2, bool FP8 = false>
__device__ __forceinline__ void gemm_phase(PG8_LAS unsigned char* lds, const Sched& S, const Epi& E, const int wid) {
    const int lane = lane_id_now(), tid = wid * 64 + lane, wr = wid >> 2, wc = wid & 3, fr = lane & 15, fq = lane >> 4;
    constexpr int nt = K / BK;
    unsigned voffA, voffB;
    { int R, C; stage_rc(tid * 16, R, C); const int Rb = Epi::PERM ? ((R & ~31) + perm32(R & 31)) : R;
        voffA = (unsigned)(R * K + C) * 2u; voffB = (unsigned)(Rb * K + C) * 2u; }
    constexpr size_t pstep = (size_t)64 * K * 2;
    constexpr size_t kstep = (size_t)(BK * 2);
    constexpr size_t hstep = (size_t)HALF * K * 2;
    constexpr size_t tstep = 2 * hstep;
    const unsigned ldsw = (unsigned)wid * 1024u;
    const int aoff = lds_byte(wr * 64 + fr, fq * 8), boff = lds_byte(wc * 32 + fr, fq * 8);
#define PG8_SA(b, h) (((b) * 2 + (h)) * HTB)
#define PG8_SB(b, h) ((4 + (b) * 2 + (h)) * HTB)
#define PG8_STAGE(bufoff, gbase, voff) do { _Pragma("unroll") for (int _i = 0; _i < 2; ++_i) \
        __builtin_amdgcn_global_load_lds((const unsigned*)((const char*)(gbase) + _i * pstep + (voff)), (PG8_LAS unsigned*)(lds + (bufoff) + ldsw + _i * 8192), 16, 0, 0); } while (0)
#define PG8_LDA(dst, b, h) do { _Pragma("unroll") for (int m = 0; m < 4; ++m) _Pragma("unroll") for (int k = 0; k < 2; ++k) dst[m][k] = *(const PG8_LAS bf16x8*)(lds + PG8_SA(b, h) + aoff + m * 2048 + k * 1024); } while (0)
#define PG8_LDB(dst, b, h) do { _Pragma("unroll") for (int n = 0; n < 2; ++n) _Pragma("unroll") for (int k = 0; k < 2; ++k) dst[n][k] = *(const PG8_LAS bf16x8*)(lds + PG8_SB(b, h) + boff + n * 2048 + k * 1024); } while (0)
#define PG8_MMA(ai, bj, At, Bt) do { __builtin_amdgcn_s_setprio(1); _Pragma("unroll") for (int m = 0; m < 4; ++m) _Pragma("unroll") for (int n = 0; n < 2; ++n) { \
        if constexpr (FP8) {   \
            const i32x8 fa_ = __builtin_bit_cast(i32x8, __builtin_shufflevector(At[m][0], At[m][1], 0, 1, 2, 3, 4, 5, 6, 7, 8, 9, 10, 11, 12, 13, 14, 15)); \
            const i32x8 fb_ = __builtin_bit_cast(i32x8, __builtin_shufflevector(Bt[n][0], Bt[n][1], 0, 1, 2, 3, 4, 5, 6, 7, 8, 9, 10, 11, 12, 13, 14, 15)); \
            acc[ai][bj][m][n] = __builtin_amdgcn_mfma_scale_f32_16x16x128_f8f6f4(fb_, fa_, acc[ai][bj][m][n], 0, 0, 0, 0x7f7f7f7f, 0, 0x7f7f7f7f); \
        } else { _Pragma("unroll") for (int k = 0; k < 2; ++k) acc[ai][bj][m][n] = __builtin_amdgcn_mfma_f32_16x16x32_bf16(Bt[n][k], At[m][k], acc[ai][bj][m][n], 0, 0, 0); } } \
        __builtin_amdgcn_s_setprio(0); } while (0)
#define PG8_WAIT_V(n) asm volatile("s_waitcnt vmcnt(" #n ")" ::: "memory")
#define PG8_WAIT_L(n) asm volatile("s_waitcnt lgkmcnt(" #n ")" ::: "memory")
#define PG8_BAR __builtin_amdgcn_s_barrier()
#define PG8_SCHED __builtin_amdgcn_sched_barrier(0)
    Unit cur, nxt; int ui = 0;
    if (!S.next(0, cur)) return;
    f32x4 acc[2][2][4][2];
#pragma unroll
    for (int a = 0; a < 2; ++a)
#pragma unroll
        for (int b = 0; b < 2; ++b)
#pragma unroll
            for (int m = 0; m < 4; ++m)
#pragma unroll
                for (int n = 0; n < 2; ++n) acc[a][b][m][n] = (f32x4){0.f, 0.f, 0.f, 0.f};
    bf16x8 At[4][2], B0[2][2], B1[2][2];
    const char* cA = (const char*)S.pa(cur) + (size_t)cur.pm * tstep; const char* cB = (const char*)S.pb(cur) + (size_t)cur.pn * tstep;
    if constexpr (SP2) {
        PG8_STAGE(PG8_SB(0, 0), cB, voffB); PG8_STAGE(PG8_SB(0, 1), cB + hstep, voffB); PG8_STAGE(PG8_SA(0, 0), cA, voffA); PG8_STAGE(PG8_SA(0, 1), cA + hstep, voffA);
        if (wr == 1) PG8_BAR;
        PG8_WAIT_V(2); PG8_BAR;
        PG8_STAGE(PG8_SB(1, 0), cB + kstep, voffB); PG8_STAGE(PG8_SA(1, 0), cA + kstep, voffA); PG8_STAGE(PG8_SB(1, 1), cB + hstep + kstep, voffB);
        PG8_WAIT_V(6); PG8_BAR;
    } else {
        PG8_STAGE(PG8_SB(0, 0), cB, voffB); PG8_STAGE(PG8_SA(0, 0), cA, voffA); PG8_STAGE(PG8_SB(0, 1), cB + hstep, voffB); PG8_STAGE(PG8_SA(0, 1), cA + hstep, voffA);
        if (wr == 1) PG8_BAR;
        PG8_WAIT_V(4); PG8_BAR;
        PG8_STAGE(PG8_SB(1, 0), cB + kstep, voffB); PG8_STAGE(PG8_SA(1, 0), cA + kstep, voffA); PG8_STAGE(PG8_SB(1, 1), cB + hstep + kstep, voffB);
        PG8_WAIT_V(6); PG8_BAR;
    }
    for (;;) {
        const bool has_next = S.next(ui + 1, nxt);
        if (!has_next) S.last_unit(wid, lane);
        const char* nA = has_next ? (const char*)S.pa(nxt) + (size_t)nxt.pm * tstep : cA; const char* nB = has_next ? (const char*)S.pb(nxt) + (size_t)nxt.pn * tstep : cB;
#pragma unroll 1
        for (int t = 0; t < nt; t += 2) {
            const bool last = (t == nt - 2);
            const char* a1 = uni(cA + (size_t)(t + 1) * kstep);
            const char* a2 = uni(last ? nA : cA + (size_t)(t + 2) * kstep); const char* b2 = uni(last ? nB : cB + (size_t)(t + 2) * kstep);
            const char* a3 = a2 + kstep; const char* b3 = b2 + kstep;
            if constexpr (SP2) {
            PG8_LDB(B0, 0, 0); PG8_LDB(B1, 0, 1); PG8_SCHED; PG8_LDA(At, 0, 0); PG8_STAGE(PG8_SA(1, 1), a1 + hstep, voffA);
            PG8_WAIT_V(8); PG8_WAIT_L(0); PG8_BAR; PG8_MMA(0, 0, At, B0); PG8_MMA(0, 1, At, B1); PG8_BAR; PG8_SCHED;
            PG8_LDA(At, 0, 1); PG8_STAGE(PG8_SB(0, 0), b2, voffB); PG8_STAGE(PG8_SB(0, 1), b2 + hstep, voffB); PG8_STAGE(PG8_SA(0, 0), a2, voffA);
            PG8_WAIT_V(8); PG8_WAIT_L(0); PG8_BAR; PG8_MMA(1, 0, At, B0); PG8_MMA(1, 1, At, B1); PG8_BAR; PG8_SCHED;
            PG8_LDB(B0, 1, 0); PG8_LDB(B1, 1, 1); PG8_SCHED; PG8_LDA(At, 1, 0); PG8_STAGE(PG8_SA(0, 1), a2 + hstep, voffA);
            PG8_WAIT_V(8); PG8_WAIT_L(0); PG8_BAR; PG8_MMA(0, 0, At, B0); PG8_MMA(0, 1, At, B1); PG8_BAR; PG8_SCHED;
            PG8_LDA(At, 1, 1); PG8_STAGE(PG8_SB(1, 0), b3, voffB); PG8_STAGE(PG8_SB(1, 1), b3 + hstep, voffB); PG8_STAGE(PG8_SA(1, 0), a3, voffA);
            PG8_WAIT_V(8); PG8_WAIT_L(0); PG8_BAR; PG8_MMA(1, 0, At, B0); PG8_MMA(1, 1, At, B1); PG8_BAR; PG8_SCHED;
            } else {
            PG8_LDB(B0, 0, 0); PG8_SCHED; PG8_LDA(At, 0, 0); PG8_STAGE(PG8_SA(1, 1), a1 + hstep, voffA);
            PG8_WAIT_L(8); PG8_BAR; PG8_WAIT_L(0); PG8_MMA(0, 0, At, B0); PG8_BAR; PG8_SCHED;
            PG8_LDB(B1, 0, 1); PG8_STAGE(PG8_SB(0, 0), b2, voffB);
            PG8_BAR; PG8_WAIT_L(0); PG8_MMA(0, 1, At, B1); PG8_BAR;
            PG8_LDA(At, 0, 1); PG8_STAGE(PG8_SA(0, 0), a2, voffA);
            PG8_BAR; PG8_WAIT_L(0); PG8_MMA(1, 0, At, B0); PG8_BAR; PG8_SCHED;
            PG8_STAGE(PG8_SB(0, 1), b2 + hstep, voffB);
            PG8_WAIT_V(6); PG8_BAR; PG8_MMA(1, 1, At, B1); PG8_BAR;
            PG8_LDB(B0, 1, 0); PG8_SCHED; PG8_LDA(At, 1, 0); PG8_STAGE(PG8_SA(0, 1), a2 + hstep, voffA);
            PG8_WAIT_L(8); PG8_BAR; PG8_WAIT_L(0); PG8_MMA(0, 0, At, B0); PG8_BAR; PG8_SCHED;
            PG8_LDB(B1, 1, 1); PG8_STAGE(PG8_SB(1, 0), b3, voffB);
            PG8_BAR; PG8_WAIT_L(0); PG8_MMA(0, 1, At, B1); PG8_BAR;
            PG8_LDA(At, 1, 1); PG8_STAGE(PG8_SA(1, 0), a3, voffA);
            PG8_BAR; PG8_WAIT_L(0); PG8_MMA(1, 0, At, B0); PG8_BAR; PG8_SCHED;
            PG8_STAGE(PG8_SB(1, 1), b3 + hstep, voffB);
            PG8_WAIT_V(6); PG8_BAR; PG8_MMA(1, 1, At, B1); PG8_BAR;
            }
        }
        if constexpr (ALIGN_EPI) { if (wr == 0) PG8_BAR; }
        const bool keep = E(acc, cur, wr, wc, fr, fq);
        if (!has_next) break;
        if (!keep) {
#pragma unroll
            for (int a = 0; a < 2; ++a)
#pragma unroll
                for (int b = 0; b < 2; ++b)
#pragma unroll
                    for (int m = 0; m < 4; ++m)
#pragma unroll
                        for (int n = 0; n < 2; ++n) acc[a][b][m][n] = (f32x4){0.f, 0.f, 0.f, 0.f};
        }
        cur = nxt; cA = nA; cB = nB; ++ui;
        if constexpr (ALIGN_EPI) { if (wr == 1) PG8_BAR; }
    }
    PG8_WAIT_V(0);
    if constexpr (!ALIGN_EPI) { if (wr == 0) PG8_BAR; }
    PG8_BAR;
#undef PG8_SA
#undef PG8_SB
#undef PG8_STAGE
#undef PG8_LDA
#undef PG8_LDB
#undef PG8_MMA
#undef PG8_WAIT_V
#undef PG8_WAIT_L
#undef PG8_BAR
#undef PG8_SCHED
}
}

typedef unsigned short bf16;
typedef unsigned v4u __attribute__((ext_vector_type(4)));
typedef unsigned v2u __attribute__((ext_vector_type(2)));
typedef float f32x4 __attribute__((ext_vector_type(4)));
typedef float f32x16 __attribute__((ext_vector_type(16)));
typedef short bf16x8 __attribute__((ext_vector_type(8)));
typedef GAS unsigned gu32;

constexpr int NWAVES = 8, NTHR = 512;
constexpr int BATCH = 8, SEQ = 2048, T = BATCH * SEQ, D = 1024;
constexpr int NH = 4, DK = 128, DV = 256, CH = 128, NCH = SEQ / CH;
constexpr int QK = NH * DK, VD = NH * DV;
constexpr int RANK = 16;
constexpr int NE = 16, CAP = 256, DFF = 2816, EROWS = BATCH * CAP;
constexpr int DIN = 8224, DINP = 8448;
constexpr float EPS = 1e-6f;
constexpr int NPHASE = 12;

constexpr size_t MiB = 1u << 20;
constexpr size_t WS_CTL = 0, CTL_ZERO_BYTES = 1 * MiB;
constexpr size_t WS_WBR = 1 * MiB, WS_WBG = 3 * MiB, WS_WOUT = 5 * MiB;
constexpr size_t WS_AL = 7 * MiB, WS_BE = 8 * MiB;
constexpr size_t WS_AFF = 9 * MiB;
constexpr size_t WS_RK = 10 * MiB;
constexpr size_t WS_GATEV = 11 * MiB;
constexpr size_t WS_GA = 12 * MiB;
constexpr size_t WS_WGU = 16 * MiB;
constexpr size_t WS_R0 = 192 * MiB;
constexpr size_t WS_R1 = 256 * MiB;
constexpr size_t WS_R2 = 320 * MiB;
constexpr size_t WS_R3 = 384 * MiB;
constexpr size_t WS_R4 = 512 * MiB;
constexpr size_t WS_QKR = WS_R0, WS_RO = WS_R0, WS_Y = WS_R0;
constexpr size_t WS_V = WS_R1, WS_MERGED = WS_R1, WS_H2 = WS_R1 + 32 * MiB;
constexpr size_t WS_G = WS_R2, WS_XG = WS_R2;
constexpr size_t WS_QT = WS_R3, WS_KT = WS_R3 + 64 * MiB, WS_ACT = WS_R3;
constexpr size_t WS_XN = WS_R4, WS_WIN = WS_R4 + 32 * MiB, WS_RT = WS_R4;
constexpr size_t WS_WDN = MOE_FP8 ? 104 * MiB : 560 * MiB;
constexpr size_t WS_END = 648 * MiB;
static_assert(MOE_FP8 ? (WS_WGU + (size_t)NE * 2 * DFF * D <= WS_WDN && WS_WDN + (size_t)NE * D * DFF <= WS_R0) : (WS_ACT + (size_t)NE * EROWS * DFF * 2 <= WS_WDN && WS_WDN + (size_t)NE * D * DFF * 2 <= WS_END), "WDN placement");
static_assert(WS_WIN + (size_t)DINP * D * 2 <= WS_R4 + 128 * MiB, "WIN fits");
constexpr int CW_CONVQ = 64;
constexpr int CW_DONE = 128;
constexpr int CW_BAR = 4096;

constexpr int RING_BYTES = 131072;
constexpr int LDSCTL_OFF = RING_BYTES, MISC_OFF = LDSCTL_OFF + 320;
constexpr int LDS_BYTES = 147456;

#define RLX_AGENT __ATOMIC_RELAXED, __HIP_MEMORY_SCOPE_AGENT
#define LDS_WAIT() asm volatile("s_waitcnt lgkmcnt(0)" ::: "memory")
#define VM_WAIT() asm volatile("s_waitcnt vmcnt(0)" ::: "memory")
__device__ __forceinline__ unsigned f2bf(float f) { unsigned u = __builtin_bit_cast(unsigned, f); return (u + 0x7fffu + ((u >> 16) & 1u)) >> 16; }
__device__ __forceinline__ unsigned pk2(float lo, float hi) { unsigned r; asm("v_cvt_pk_bf16_f32 %0, %1, %2" : "=v"(r) : "v"(lo), "v"(hi)); return r; }
__device__ __forceinline__ float bf2f(unsigned u16) { return __builtin_bit_cast(float, u16 << 16); }
__device__ __forceinline__ float bflo(unsigned w) { return __builtin_bit_cast(float, w << 16); }
__device__ __forceinline__ float bfhi(unsigned w) { return __builtin_bit_cast(float, w & 0xffff0000u); }
__device__ __forceinline__ unsigned pk4_fp8(float a, float b, float c, float d) {
    a = __builtin_amdgcn_fmed3f(a, -448.f, 448.f); b = __builtin_amdgcn_fmed3f(b, -448.f, 448.f); c = __builtin_amdgcn_fmed3f(c, -448.f, 448.f); d = __builtin_amdgcn_fmed3f(d, -448.f, 448.f);
    int w = 0; w = __builtin_amdgcn_cvt_pk_fp8_f32(a, b, w, false); w = __builtin_amdgcn_cvt_pk_fp8_f32(c, d, w, true); return (unsigned)w; }
constexpr float SC_W = 256.f, SC_H = 8.f, SC_A = 4.f;
__device__ __forceinline__ float fast_sigmoid(float x) { return __builtin_amdgcn_rcpf(1.0f + __builtin_amdgcn_exp2f(-1.4426950408889634f * x)); }
__device__ __forceinline__ float fast_silu(float x) { return x * fast_sigmoid(x); }
__device__ __forceinline__ float log_sigmoid(float z) { return fminf(z, 0.f) - log1pf(expf(-fabsf(z))); }
__device__ __forceinline__ float fexp(float x) { return __builtin_amdgcn_exp2f(1.4426950408889634f * x); }
__device__ __forceinline__ float fast_log_sigmoid(float z) { return fminf(z, 0.f) - 0.6931471805599453f * __builtin_amdgcn_logf(1.0f + fexp(-fabsf(z))); }

#define XB_TMO      128
#define XB_XCNT(j)  (256  + 64 * (j))
#define XB_XSUB(j)  (1280 + 64 * (j))
#define XB_XGEN(j)  (2304 + 64 * (j))
#define XB_TOP      3328
#define XB_TOPGEN   3392
#define XCD_BAR_WORDS 3456
#define XB_SPIN_CAP (1u << 20)
__device__ __forceinline__ unsigned xb_ld(unsigned* p)              { return __hip_atomic_load(p, __ATOMIC_RELAXED, __HIP_MEMORY_SCOPE_AGENT); }
__device__ __forceinline__ unsigned xb_add(unsigned* p, unsigned v) { return __hip_atomic_fetch_add(p, v, __ATOMIC_RELAXED, __HIP_MEMORY_SCOPE_AGENT); }
__device__ __forceinline__ unsigned xb_xcc_id() { return (unsigned)__builtin_amdgcn_s_getreg((3 << 11) | 20) & 0xFu; }
#define XB_SPIN(cond, bar) do { unsigned _sp = 0; while (cond) { __builtin_amdgcn_s_sleep(1); \
    if ((++_sp & 255u) == 0u) { if (xb_ld(&(bar)[XB_TMO])) break; if (_sp > XB_SPIN_CAP) { atomicAdd(&(bar)[XB_TMO], 1u); break; } } } } while (0)
struct XcdBarrier { unsigned* bar; unsigned x; volatile LAS unsigned* st; unsigned G; int wave; };
__device__ __forceinline__ XcdBarrier xcd_barrier_post(unsigned* bar, volatile LAS unsigned* st, int wave) {
    XcdBarrier b; b.bar = bar; b.x = xb_xcc_id(); b.st = st; b.G = 0; b.wave = wave;
    if (wave == 0 && lane_id_now() == 0) (void)xb_add(&bar[XB_XCNT(b.x)], 1u);
    return b;
}
__device__ __forceinline__ void xcd_barrier_complete(unsigned* bar, unsigned x, unsigned G_, unsigned& nloc, unsigned& nx) {
    const unsigned G = (unsigned)__builtin_amdgcn_readfirstlane(G_);
    unsigned sum, cnt, mine, sp = 0u;
    for (;;) {
        sum = 0u; cnt = 0u; mine = 0u;
#pragma unroll
        for (unsigned j = 0; j < 16; ++j) { const unsigned c = xb_ld(&bar[XB_XCNT(j)]); sum += c; cnt += (c > 0u) ? 1u : 0u; mine = (j == x) ? c : mine; }
        if ((unsigned)__builtin_amdgcn_readfirstlane(sum) == G) break;
        __builtin_amdgcn_s_sleep(1);
        if ((++sp & 255u) == 0u) { if (xb_ld(&bar[XB_TMO])) break; if (sp > XB_SPIN_CAP) { atomicAdd(&bar[XB_TMO], 1u); break; } }
    }
    nloc = mine > 0u ? mine : 1u; nx = cnt > 0u ? cnt : 1u;
}
__device__ __forceinline__ void xcd_barrier(const XcdBarrier& b, const unsigned G) {
    asm volatile("s_waitcnt vmcnt(0)" ::: "memory");
    __syncthreads();
    if (b.wave == 0 && lane_id_now() == 0) {
        unsigned* bar = b.bar;
        __builtin_amdgcn_s_waitcnt(0);
        unsigned nloc = b.st[0], nx = b.st[1];
        if (nloc == 0u) { xcd_barrier_complete(bar, b.x, G, nloc, nx); b.st[0] = nloc; b.st[1] = nx; }
        const unsigned old = xb_add(&bar[XB_XSUB(b.x)], 1u);
        const unsigned gen = old / nloc;
        if (old + 1u == (gen + 1u) * nloc) {
            __builtin_amdgcn_fence(__ATOMIC_RELEASE, "agent");
            asm volatile("s_waitcnt vmcnt(0)" ::: "memory");
            const unsigned og = xb_add(&bar[XB_TOP], 1u);
            const unsigned tg = og / nx;
            if (og + 1u == (tg + 1u) * nx) xb_add(&bar[XB_TOPGEN], 1u);
            else XB_SPIN(xb_ld(&bar[XB_TOPGEN]) == tg, bar);
            __builtin_amdgcn_fence(__ATOMIC_ACQUIRE, "agent");
            xb_add(&bar[XB_XGEN(b.x)], 1u);
            asm volatile("s_waitcnt vmcnt(0)" ::: "memory");
        } else {
            XB_SPIN(xb_ld(&bar[XB_XGEN(b.x)]) == gen, bar);
            __builtin_amdgcn_fence(__ATOMIC_ACQUIRE, "agent");
            asm volatile("s_waitcnt vmcnt(0)" ::: "memory");
        }
    }
    __syncthreads();
}

struct Args { const float* in[21]; float* out; unsigned char* ws; int ph_lo, ph_hi, dup, grid; };
struct Frame {
    LAS unsigned char* lds;
    int tid, lane, wave, vcu, G;
    float* out; unsigned char* ws;
};
#define IN_X 0
#define IN_POS 1
#define IN_NORM_MIX 2
#define IN_W_IN 3
#define IN_RDF 4
#define IN_RDB 5
#define IN_RET_NORM 6
#define IN_GWF 7
#define IN_GBF 8
#define IN_GWB 9
#define IN_GBB 10
#define IN_GLA_NORM 11
#define IN_WBR 12
#define IN_WBG 13
#define IN_WOUT 14
#define IN_NORM_FFN 15
#define IN_W_ROUTER 16
#define IN_W_GATE 17
#define IN_W_UP 18
#define IN_W_DOWN 19
#define IN_NORM_FINAL 20

__device__ __forceinline__ float wave_sum(float v) {
#pragma unroll
    for (int o = 1; o < 64; o <<= 1) v += __shfl_xor(v, o);
    return v;
}

struct TrItem { const float* W; bf16* WT; int N, K, kb, n0, drow0, f8; };
__device__ __forceinline__ void tr_load(const TrItem& t, int lane, f32x4 (&v)[8]) {
    const int k0 = 64 * t.kb, c4 = lane & 7, r8 = lane >> 3;
#pragma unroll
    for (int i = 0; i < 8; ++i) v[i] = __builtin_nontemporal_load((const f32x4*)(t.W + (size_t)(k0 + 8 * i + r8) * t.N + t.n0 + 4 * c4));
}
__device__ __forceinline__ void tr_finish(const TrItem& t, int lane, const f32x4 (&v)[8], LAS float* scr) {
    const int k0 = 64 * t.kb, c4 = lane & 7, r8 = lane >> 3;
#pragma unroll
    for (int i = 0; i < 8; ++i) { LAS float* d = scr + (8 * i + r8) * 33 + 4 * c4; d[0] = v[i].x; d[1] = v[i].y; d[2] = v[i].z; d[3] = v[i].w; }
    LDS_WAIT(); asm volatile("" ::: "memory");
    const int c = lane & 7;
    if (t.f8) {
#pragma unroll
        for (int j = 0; j < 4; ++j) { const int n = (lane >> 3) + 8 * j; const LAS float* s = scr + (8 * c) * 33 + n;
            v2u o; o.x = pk4_fp8(s[0 * 33] * SC_W, s[1 * 33] * SC_W, s[2 * 33] * SC_W, s[3 * 33] * SC_W); o.y = pk4_fp8(s[4 * 33] * SC_W, s[5 * 33] * SC_W, s[6 * 33] * SC_W, s[7 * 33] * SC_W);
            *(GAS v2u*)((unsigned char*)t.WT + (size_t)(t.drow0 + n) * t.K + k0 + 8 * c) = o; }
    } else {
#pragma unroll
        for (int j = 0; j < 4; ++j) { const int n = (lane >> 3) + 8 * j; const LAS float* s = scr + (8 * c) * 33 + n;
            v4u o; o.x = pk2(s[0 * 33], s[1 * 33]); o.y = pk2(s[2 * 33], s[3 * 33]); o.z = pk2(s[4 * 33], s[5 * 33]); o.w = pk2(s[6 * 33], s[7 * 33]);
            *(GAS v4u*)(t.WT + (size_t)(t.drow0 + n) * t.K + k0 + 8 * c) = o; }
    }
    LDS_WAIT(); asm volatile("" ::: "memory");
}
__device__ __forceinline__ void rms_row_store(int lane, const f32x4 (&v)[4], const f32x4 (&g)[4], bf16* orow) {
    float s = 0.f;
#pragma unroll
    for (int j = 0; j < 4; ++j) s += (v[j].x * v[j].x + v[j].y * v[j].y) + (v[j].z * v[j].z + v[j].w * v[j].w);
    const float rstd = 1.f / sqrtf(wave_sum(s) * (1.f / D) + EPS);
    GAS v2u* o8 = (GAS v2u*)orow + lane;
#pragma unroll
    for (int j = 0; j < 4; ++j) { v2u o; o.x = pk2(v[j].x * rstd * g[j].x, v[j].y * rstd * g[j].y); o.y = pk2(v[j].z * rstd * g[j].z, v[j].w * rstd * g[j].w); o8[64 * j] = o; }
}

constexpr int P0_I_IN = (D / 64) * (DIN / 32);
constexpr int P0_I_SQ = (D / 64) * (D / 32);
constexpr int P0_NSTATIC = P0_I_IN + 3 * P0_I_SQ;
constexpr int QY_PER = (D / 128) * (DFF / 32);
constexpr int Q_GU1 = NE * QY_PER;
constexpr int Q_GU = 2 * Q_GU1, Q_DN = NE * QY_PER, Q_N = Q_GU + Q_DN;
constexpr int NG1 = 176;
constexpr int P1_ROUNDS = (64 * 33 + NG1 - 1) / NG1, P1_LATE = 64 * 33 - NG1 * (P1_ROUNDS - 1), P1_EARLY = NG1 - P1_LATE;
constexpr int Q_P1 = MOE_FP8 ? Q_N : Q_GU;
constexpr int QCH = 6;
template <int LIST> __device__ __forceinline__ void cv_decode(const Frame& F, const Args& A, int it, TrItem& t) {
    if (LIST == 0) {
        int r = it;
        if (r < P0_I_IN) { const int nblk = DIN / 32, kb = r / nblk, nb = r % nblk, n0 = 32 * nb;
            t.f8 = 0; t.W = A.in[IN_W_IN]; t.WT = (bf16*)(F.ws + WS_WIN); t.N = DIN; t.K = D; t.kb = kb; t.n0 = n0; t.drow0 = n0 < 6144 ? n0 : (n0 < 6176 ? 8192 + (n0 - 6144) : n0 - 32); return; }
        r -= P0_I_IN;
        { const int w = r / P0_I_SQ, q = r % P0_I_SQ;
          t.W = w == 0 ? A.in[IN_WBR] : (w == 1 ? A.in[IN_WBG] : A.in[IN_WOUT]); t.WT = (bf16*)(F.ws + (w == 0 ? WS_WBR : (w == 1 ? WS_WBG : WS_WOUT)));
          t.f8 = 0; t.N = D; t.K = D; t.kb = q / 32; t.n0 = 32 * (q % 32); t.drow0 = t.n0; }
    }
}
static_assert(MOE_FP8 == 1, "the expert-weight stream writes fp8 rows");
struct YItem { const float* src; unsigned char* dst; int N, K; };
__device__ __forceinline__ void y_decode(const Frame& F, const Args& A, int it, YItem& t) {
    if (it < Q_GU) { const int up = it / Q_GU1, q = it % Q_GU1, e = q / QY_PER, q2 = q % QY_PER, k0 = 128 * (q2 / (DFF / 32)), n0 = 32 * (q2 % (DFF / 32));
        const int drow0 = 256 * (n0 >> 7) + (n0 & 127) + (up ? 128 : 0);
        t.src = (up ? A.in[IN_W_UP] : A.in[IN_W_GATE]) + (size_t)e * D * DFF + (size_t)k0 * DFF + n0; t.N = DFF;
        t.dst = F.ws + WS_WGU + (size_t)e * (2 * DFF) * D + (size_t)drow0 * D + k0; t.K = D; return; }
    { const int r = it - Q_GU, e = r / QY_PER, q = r % QY_PER, k0 = 128 * (q / (D / 32)), n0 = 32 * (q % (D / 32));
      t.src = A.in[IN_W_DOWN] + (size_t)e * DFF * D + (size_t)k0 * D + n0; t.N = D;
      t.dst = F.ws + WS_WDN + (size_t)e * D * DFF + (size_t)n0 * DFF + k0; t.K = DFF; }
}
__device__ __forceinline__ void y_ld(const Frame& F, const Args& A, int it, f32x4 (&v)[16]) {
    YItem t; y_decode(F, A, it, t); const int r8 = F.lane >> 3, c4 = F.lane & 7;
    const float* p = t.src + (size_t)(16 * r8) * t.N + 4 * c4;
#pragma unroll
    for (int i = 0; i < 16; ++i) v[i] = __builtin_nontemporal_load((const f32x4*)(p + (size_t)i * t.N));
}
__device__ __forceinline__ void y_fin(const Frame& F, const Args& A, int it, const f32x4 (&v)[16]) {
    YItem t; y_decode(F, A, it, t); const int r8 = F.lane >> 3, c4 = F.lane & 7;
    unsigned char* d = t.dst + (size_t)(4 * c4) * t.K + 16 * r8;
#pragma unroll
    for (int x = 0; x < 4; ++x) { v4u o;
        o.x = pk4_fp8(v[0][x] * SC_W, v[1][x] * SC_W, v[2][x] * SC_W, v[3][x] * SC_W);     o.y = pk4_fp8(v[4][x] * SC_W, v[5][x] * SC_W, v[6][x] * SC_W, v[7][x] * SC_W);
        o.z = pk4_fp8(v[8][x] * SC_W, v[9][x] * SC_W, v[10][x] * SC_W, v[11][x] * SC_W);   o.w = pk4_fp8(v[12][x] * SC_W, v[13][x] * SC_W, v[14][x] * SC_W, v[15][x] * SC_W);
        *(GAS v4u*)(d + (size_t)x * t.K) = o; }
}
__device__ __forceinline__ void y_range(Frame& F, const Args& A, int first, int last, int stride) {
    if (first >= last) return;
    const int n = (last - first + stride - 1) / stride;
#define Y_IDX(k) (first + ((k) < n ? (k) : n - 1) * stride)
    f32x4 va[16], vb[16], vc[16];
    y_ld(F, A, Y_IDX(0), va); y_ld(F, A, Y_IDX(1), vb);
    for (int i = 0; i < n; i += 3) {
        y_ld(F, A, Y_IDX(i + 2), vc); y_fin(F, A, Y_IDX(i), va);
        y_ld(F, A, Y_IDX(i + 3), va); y_fin(F, A, Y_IDX(i + 1), vb);
        y_ld(F, A, Y_IDX(i + 4), vb); y_fin(F, A, Y_IDX(i + 2), vc);
    }
#undef Y_IDX
}
template <int LIST> __device__ __forceinline__ void cv_ld(const Frame& F, const Args& A, int it, f32x4 (&v)[8]) { TrItem t; cv_decode<LIST>(F, A, it, t); tr_load(t, F.lane, v); }
template <int LIST> __device__ __forceinline__ void cv_fin(const Frame& F, const Args& A, int it, const f32x4 (&v)[8], LAS float* scr) { TrItem t; cv_decode<LIST>(F, A, it, t); tr_finish(t, F.lane, v, scr); }
template <int LIST> __device__ __forceinline__ void cv_range(Frame& F, const Args& A, int first, int last, int stride, LAS float* scr) {
    if (first >= last) return;
    const int n = (last - first + stride - 1) / stride;
#define CV_IDX(k) (first + ((k) < n ? (k) : n - 1) * stride)
    f32x4 va[8], vb[8], vc[8];
    cv_ld<LIST>(F, A, CV_IDX(0), va); cv_ld<LIST>(F, A, CV_IDX(1), vb);
    for (int i = 0; i < n; i += 3) {
        cv_ld<LIST>(F, A, CV_IDX(i + 2), vc); cv_fin<LIST>(F, A, CV_IDX(i), va, scr);
        cv_ld<LIST>(F, A, CV_IDX(i + 3), va); cv_fin<LIST>(F, A, CV_IDX(i + 1), vb, scr);
        cv_ld<LIST>(F, A, CV_IDX(i + 4), vb); cv_fin<LIST>(F, A, CV_IDX(i + 2), vc, scr);
    }
#undef CV_IDX
}
__device__ __forceinline__ void p0_prologue(Frame& F, const Args& A) {
    LAS float* scr = (LAS float*)(F.lds + F.wave * 16384);
    const int gw = F.vcu * NWAVES + F.wave, NGW = F.G * NWAVES;
    bf16* WIN = (bf16*)(F.ws + WS_WIN);
    cv_range<0>(F, A, gw, P0_NSTATIC, NGW, scr);
    if (F.G != 256) y_range(F, A, gw, Q_N, NGW);
    for (int i = gw * 64 + F.lane; i < (DINP - DIN) * D / 8; i += NGW * 64) *(GAS v4u*)(WIN + (size_t)DIN * D + (size_t)i * 8) = (v4u){0u, 0u, 0u, 0u};
    bf16* XN = (bf16*)(F.ws + WS_XN);
    { f32x4 gm[4];
#pragma unroll
      for (int j = 0; j < 4; ++j) gm[j] = *((const GAS f32x4*)A.in[IN_NORM_MIX] + F.lane + 64 * j);
      for (int m0 = gw; m0 < T; m0 += 2 * NGW) {
          f32x4 va[4], vb[4]; const int m1 = m0 + NGW;
#pragma unroll
          for (int j = 0; j < 4; ++j) { va[j] = *((const GAS f32x4*)(A.in[IN_X] + (size_t)m0 * D) + F.lane + 64 * j); vb[j] = *((const GAS f32x4*)(A.in[IN_X] + (size_t)(m1 < T ? m1 : m0) * D) + F.lane + 64 * j); }
          rms_row_store(F.lane, va, gm, XN + (size_t)m0 * D);
          if (m1 < T) rms_row_store(F.lane, vb, gm, XN + (size_t)m1 * D);
      } }
}
struct P1Pull { unsigned d, it0; };
__device__ __forceinline__ P1Pull p1_pull_issue(gu32* ctr, gu32* done, int lane) {
    P1Pull r;
    if (lane == 0) { r.d = __hip_atomic_load(done, RLX_AGENT); const unsigned q_ = (unsigned)QCH; asm volatile("global_atomic_add %0, %1, %2, off sc0" : "=v"(r.it0) : "v"(ctr), "v"(q_) : "memory"); }
    return r;
}
__device__ __forceinline__ void p1_stream(Frame& F, const Args& A) {
    static_assert(QCH == 6, "the loop body below is written for chunks of six");
    gu32* ctr = (gu32*)(F.ws + WS_CTL) + CW_CONVQ; gu32* done = (gu32*)(F.ws + WS_CTL) + CW_DONE;
#define QI(base, k) ((base) + (k) < Q_P1 ? (base) + (k) : Q_P1 - 1)
    unsigned d0 = 0, t0 = 0;
    if (F.lane == 0) { d0 = __hip_atomic_load(done, RLX_AGENT); if (d0 <= (unsigned)P1_EARLY) t0 = __hip_atomic_fetch_add(ctr, (unsigned)QCH, RLX_AGENT); }
    d0 = __builtin_amdgcn_readfirstlane(d0); t0 = __builtin_amdgcn_readfirstlane(t0);
    if (d0 > (unsigned)P1_EARLY || t0 >= (unsigned)Q_P1) return;
    int i0 = (int)t0; bool stopping = false;
    f32x4 va[16], vb[16], vc[16];
    y_ld(F, A, QI(i0, 0), va); y_ld(F, A, QI(i0, 1), vb);
    for (;;) {
        P1Pull pr; if (!stopping) pr = p1_pull_issue(ctr, done, F.lane);
        y_ld(F, A, QI(i0, 2), vc); y_fin(F, A, QI(i0, 0), va);
        y_ld(F, A, QI(i0, 3), va); y_fin(F, A, QI(i0, 1), vb);
        y_ld(F, A, QI(i0, 4), vb); y_fin(F, A, QI(i0, 2), vc);
        y_ld(F, A, QI(i0, 5), vc); y_fin(F, A, QI(i0, 3), va);
        __builtin_amdgcn_sched_barrier(0);
        int it1 = -1; bool stop_next = true;
        if (!stopping) { const unsigned d = __builtin_amdgcn_readfirstlane(pr.d), t = __builtin_amdgcn_readfirstlane(pr.it0); it1 = t < (unsigned)Q_P1 ? (int)t : -1; stop_next = d > (unsigned)P1_EARLY; }
        const int i1 = it1 >= 0 ? it1 : i0;
        y_ld(F, A, QI(i1, 0), va); y_fin(F, A, QI(i0, 4), vb);
        y_ld(F, A, QI(i1, 1), vb); y_fin(F, A, QI(i0, 5), vc);
        if (it1 < 0) break;
        i0 = i1; stopping = stop_next;
    }
#undef QI
}

struct SchedPlain {
    int nM, nN, G, c; const bf16* A; const bf16* Bt; gu32* lastctr;
    __device__ __forceinline__ void last_unit(int wid, int lane) const { if (lastctr && wid == 0 && lane == 0) __hip_atomic_fetch_add(lastctr, 1u, RLX_AGENT); }
    __device__ __forceinline__ bool next(int i, pg8::Unit& u) const {
        const long L = (long)i * G + c; if (L >= (long)nM * nN) return false;
        pg8::tile_of((int)L, nM, nN, u.pm, u.pn); u.aux = 0; return true; }
    __device__ __forceinline__ const bf16* pa(const pg8::Unit&) const { return A; }
    __device__ __forceinline__ const bf16* pb(const pg8::Unit&) const { return Bt; }
};
struct SchedBranch {
    int G, c; const bf16* A0; const bf16* A1; const bf16* B0; const bf16* B1;
    __device__ __forceinline__ void last_unit(int, int) const {}
    __device__ __forceinline__ bool next(int i, pg8::Unit& u) const {
        const long L = (long)(i >> 1) * G + c; if (L >= 64 * 4) return false;
        pg8::tile_of((int)L, 64, 4, u.pm, u.pn); u.aux = i & 1; return true; }
    __device__ __forceinline__ const bf16* pa(const pg8::Unit& u) const { return u.aux ? A1 : A0; }
    __device__ __forceinline__ const bf16* pb(const pg8::Unit& u) const { return u.aux ? B1 : B0; }
};
struct SchedMoe {
    int NP, G, c; const bf16* A; const bf16* Bt;
    __device__ __forceinline__ void last_unit(int, int) const {}
    __device__ __forceinline__ bool next(int i, pg8::Unit& u) const {
        const int nwg = NE * 8 * NP; const long L = (long)i * G + c; if (L >= nwg) return false;
        int wgid = (int)L; { const int q = nwg / 8, xcd = wgid % 8, off = wgid / 8; wgid = xcd * q + off; }
        const int e = wgid / (8 * NP), rem = wgid % (8 * NP), pnl = rem / 8, pml = rem % 8;
        u.pm = e * 8 + pml; u.pn = e * NP + pnl; u.aux = pnl; return true; }
    __device__ __forceinline__ const bf16* pa(const pg8::Unit&) const { return A; }
    __device__ __forceinline__ const bf16* pb(const pg8::Unit&) const { return Bt; }
};

struct EpiInProj {
    static constexpr bool PERM = true;
    bf16* QKR; bf16* V; bf16* Gt; bf16* SG; float* GA;
    __device__ __forceinline__ bool operator()(pg8::f32x4 (&acc)[2][2][4][2], const pg8::Unit& u, int wr, int wc, int fr, int fq) const {
        const int pn = u.pn; const int row0 = u.pm * 256 + wr * 64 + fr;
        if (pn == 32) {
            if (wc == 0) {
#pragma unroll
                for (int ai = 0; ai < 2; ++ai)
#pragma unroll
                    for (int m = 0; m < 4; ++m) { float* rp = GA + (size_t)(row0 + ai * 128 + m * 16) * 32 + 8 * fq;
                        *(pg8::f32x4*)(rp) = acc[ai][0][m][0]; *(pg8::f32x4*)(rp + 4) = acc[ai][0][m][1]; }
            }
            return false;
        }
        bf16* base; int ldc, colt, act;
        if (pn < 2)       { base = QKR;                         ldc = QK; colt = pn * 256;        act = 0; }
        else if (pn < 4)  { base = QKR + (size_t)1 * T * QK;    ldc = QK; colt = (pn - 2) * 256;  act = 0; }
        else if (pn < 8)  { base = V;                           ldc = VD; colt = (pn - 4) * 256;  act = 0; }
        else if (pn < 12) { base = Gt;                          ldc = VD; colt = (pn - 8) * 256;  act = 1; }
        else if (pn < 14) { base = QKR + (size_t)2 * T * QK;    ldc = QK; colt = (pn - 12) * 256; act = 0; }
        else if (pn < 16) { base = QKR + (size_t)3 * T * QK;    ldc = QK; colt = (pn - 14) * 256; act = 0; }
        else if (pn < 20) { base = V + (size_t)T * VD;          ldc = VD; colt = (pn - 16) * 256; act = 0; }
        else if (pn < 24) { base = Gt + (size_t)T * VD;         ldc = VD; colt = (pn - 20) * 256; act = 1; }
        else if (pn < 28) { base = SG;                          ldc = VD; colt = (pn - 24) * 256; act = 2; }
        else              { base = SG + (size_t)T * VD;         ldc = VD; colt = (pn - 28) * 256; act = 2; }
        const int col0 = colt + wc * 32 + 8 * fq;
#pragma unroll
        for (int ai = 0; ai < 2; ++ai)
#pragma unroll
            for (int m = 0; m < 4; ++m) { bf16* rowp = base + (size_t)(row0 + ai * 128 + m * 16) * ldc + col0;
#pragma unroll
                for (int bj = 0; bj < 2; ++bj) { pg8::f32x4 v0 = acc[ai][bj][m][0], v1 = acc[ai][bj][m][1];
                    if (act == 1) {
#pragma unroll
                        for (int x = 0; x < 4; ++x) { v0[x] = fast_silu(v0[x]); v1[x] = fast_silu(v1[x]); } }
                    else if (act == 2) {
#pragma unroll
                        for (int x = 0; x < 4; ++x) { v0[x] = fast_sigmoid(v0[x]); v1[x] = fast_sigmoid(v1[x]); } }
                    pg8::u32x4 w; w.x = pg8::cvt_pk_bf16(v0[0], v0[1]); w.y = pg8::cvt_pk_bf16(v0[2], v0[3]); w.z = pg8::cvt_pk_bf16(v1[0], v1[1]); w.w = pg8::cvt_pk_bf16(v1[2], v1[3]);
                    *(pg8::u32x4*)(rowp + bj * 128) = w; } }
        return false;
    }
};
struct EpiBranch {
    static constexpr bool PERM = true;
    const bf16* SG; bf16* O;
    __device__ __forceinline__ bool operator()(pg8::f32x4 (&acc)[2][2][4][2], const pg8::Unit& u, int wr, int wc, int fr, int fq) const {
        const int row0 = u.pm * 256 + wr * 64 + fr, col0 = u.pn * 256 + wc * 32 + 8 * fq;
        if (u.aux == 0) {
#pragma unroll
            for (int ai = 0; ai < 2; ++ai) {
                pg8::u32x4 g1[4][2], g0[4][2];
#pragma unroll
                for (int m = 0; m < 4; ++m)
#pragma unroll
                    for (int bj = 0; bj < 2; ++bj) { const size_t off = (size_t)(row0 + ai * 128 + m * 16) * VD + col0 + bj * 128;
                        g1[m][bj] = *(const pg8::u32x4*)(SG + (size_t)T * VD + off); g0[m][bj] = *(const pg8::u32x4*)(SG + off); }
#pragma unroll
                for (int m = 0; m < 4; ++m)
#pragma unroll
                    for (int bj = 0; bj < 2; ++bj) { const pg8::u32x4 a1 = g1[m][bj], a0 = g0[m][bj];
                        pg8::f32x4 s1a = {bflo(a1.x), bfhi(a1.x), bflo(a1.y), bfhi(a1.y)}, s1b = {bflo(a1.z), bfhi(a1.z), bflo(a1.w), bfhi(a1.w)};
                        pg8::f32x4 s0a = {bflo(a0.x), bfhi(a0.x), bflo(a0.y), bfhi(a0.y)}, s0b = {bflo(a0.z), bfhi(a0.z), bflo(a0.w), bfhi(a0.w)};
#pragma unroll
                        for (int x = 0; x < 4; ++x) { acc[ai][bj][m][0][x] *= s0a[x] * __builtin_amdgcn_rcpf(s1a[x]); acc[ai][bj][m][1][x] *= s0b[x] * __builtin_amdgcn_rcpf(s1b[x]); } }
            }
            return true;
        }
#pragma unroll
        for (int ai = 0; ai < 2; ++ai) {
            pg8::u32x4 g1[4][2];
#pragma unroll
            for (int m = 0; m < 4; ++m)
#pragma unroll
                for (int bj = 0; bj < 2; ++bj) g1[m][bj] = *(const pg8::u32x4*)(SG + (size_t)T * VD + (size_t)(row0 + ai * 128 + m * 16) * VD + col0 + bj * 128);
#pragma unroll
            for (int m = 0; m < 4; ++m)
#pragma unroll
                for (int bj = 0; bj < 2; ++bj) { const pg8::u32x4 a1 = g1[m][bj];
                    pg8::f32x4 s1a = {bflo(a1.x), bfhi(a1.x), bflo(a1.y), bfhi(a1.y)}, s1b = {bflo(a1.z), bfhi(a1.z), bflo(a1.w), bfhi(a1.w)};
                    const pg8::f32x4 v0 = acc[ai][bj][m][0] * s1a, v1 = acc[ai][bj][m][1] * s1b;
                    pg8::u32x4 w; w.x = pg8::cvt_pk_bf16(v0[0], v0[1]); w.y = pg8::cvt_pk_bf16(v0[2], v0[3]); w.z = pg8::cvt_pk_bf16(v1[0], v1[1]); w.w = pg8::cvt_pk_bf16(v1[2], v1[3]);
                    *(pg8::u32x4*)(O + (size_t)(row0 + ai * 128 + m * 16) * VD + col0 + bj * 128) = w; }
        }
        return false;
    }
};
struct EpiOut {
    static constexpr bool PERM = false;
    const float* X; float* O;
    __device__ __forceinline__ bool operator()(pg8::f32x4 (&acc)[2][2][4][2], const pg8::Unit& u, int wr, int wc, int fr, int fq) const {
        const int row0 = u.pm * 256 + wr * 64 + fr, col0 = u.pn * 256 + wc * 32 + 4 * fq;
#pragma unroll
        for (int ai = 0; ai < 2; ++ai) {
            pg8::f32x4 xv[4][2][2];
#pragma unroll
            for (int m = 0; m < 4; ++m)
#pragma unroll
                for (int bj = 0; bj < 2; ++bj)
#pragma unroll
                    for (int n = 0; n < 2; ++n) xv[m][bj][n] = *(const pg8::f32x4*)(X + (size_t)(row0 + ai * 128 + m * 16) * D + col0 + bj * 128 + n * 16);
#pragma unroll
            for (int m = 0; m < 4; ++m)
#pragma unroll
                for (int bj = 0; bj < 2; ++bj)
#pragma unroll
                    for (int n = 0; n < 2; ++n) *(pg8::f32x4*)(O + (size_t)(row0 + ai * 128 + m * 16) * D + col0 + bj * 128 + n * 16) = xv[m][bj][n] + acc[ai][bj][m][n];
        }
        return false;
    }
};
struct EpiSwiGLU {
    static constexpr bool PERM = true;
    bf16* ACT;
    __device__ __forceinline__ bool operator()(pg8::f32x4 (&acc)[2][2][4][2], const pg8::Unit& u, int wr, int wc, int fr_, int fq_) const {
        const int l_ = lane_id_now(); const int fr = l_ & 15, fq = l_ >> 4; (void)fr_; (void)fq_;
        const int row0 = u.pm * 256 + wr * 64 + fr, col0 = u.aux * 128 + wc * 32 + 8 * fq;
#pragma unroll
        for (int ai = 0; ai < 2; ++ai)
#pragma unroll
            for (int m = 0; m < 4; ++m) { bf16* rowp = ACT + (size_t)(row0 + ai * 128 + m * 16) * DFF + col0;
                pg8::f32x4 v0, v1;
#if MOE_FP8
                constexpr float is = 1.f / (SC_W * SC_H);
#pragma unroll
                for (int x = 0; x < 4; ++x) { v0[x] = fast_silu(acc[ai][0][m][0][x] * is) * (acc[ai][1][m][0][x] * (is * SC_A)); v1[x] = fast_silu(acc[ai][0][m][1][x] * is) * (acc[ai][1][m][1][x] * (is * SC_A)); }
                pg8::u32x2 w; w.x = pk4_fp8(v0[0], v0[1], v0[2], v0[3]); w.y = pk4_fp8(v1[0], v1[1], v1[2], v1[3]);
                *(pg8::u32x2*)((unsigned char*)ACT + (size_t)(row0 + ai * 128 + m * 16) * DFF + col0) = w; (void)rowp; }
#else
#pragma unroll
                for (int x = 0; x < 4; ++x) { v0[x] = fast_silu(acc[ai][0][m][0][x]) * acc[ai][1][m][0][x]; v1[x] = fast_silu(acc[ai][0][m][1][x]) * acc[ai][1][m][1][x]; }
                pg8::u32x4 w; w.x = pg8::cvt_pk_bf16(v0[0], v0[1]); w.y = pg8::cvt_pk_bf16(v0[2], v0[3]); w.z = pg8::cvt_pk_bf16(v1[0], v1[1]); w.w = pg8::cvt_pk_bf16(v1[2], v1[3]);
                *(pg8::u32x4*)rowp = w; }
#endif
        return false;
    }
};
struct EpiDown {
    static constexpr bool PERM = true;
    const float* GATEV; bf16* Y;
    __device__ __forceinline__ bool operator()(pg8::f32x4 (&acc)[2][2][4][2], const pg8::Unit& u, int wr, int wc, int fr_, int fq_) const {
        const int l_ = lane_id_now(); const int fr = l_ & 15, fq = l_ >> 4; (void)fr_; (void)fq_;
        const int row0 = u.pm * 256 + wr * 64 + fr, col0 = u.aux * 256 + wc * 32 + 8 * fq;
        float gv[2][4];
#pragma unroll
        for (int ai = 0; ai < 2; ++ai)
#pragma unroll
            for (int m = 0; m < 4; ++m) gv[ai][m] = GATEV[row0 + ai * 128 + m * 16] * (MOE_FP8 ? 1.f / (SC_W * SC_A) : 1.f);
#pragma unroll
        for (int ai = 0; ai < 2; ++ai)
#pragma unroll
            for (int m = 0; m < 4; ++m) { const int row = row0 + ai * 128 + m * 16; const float g = gv[ai][m]; bf16* rowp = Y + (size_t)row * D + col0;
#pragma unroll
                for (int bj = 0; bj < 2; ++bj) { const pg8::f32x4 v0 = acc[ai][bj][m][0] * g, v1 = acc[ai][bj][m][1] * g;
                    pg8::u32x4 w; w.x = pg8::cvt_pk_bf16(v0[0], v0[1]); w.y = pg8::cvt_pk_bf16(v0[2], v0[3]); w.z = pg8::cvt_pk_bf16(v1[0], v1[1]); w.w = pg8::cvt_pk_bf16(v1[2], v1[3]);
                    *(pg8::u32x4*)(rowp + bj * 128) = w; } }
        return false;
    }
};

__device__ __forceinline__ size_t qt_index(int br, int dir, int t, int h, int d) { return ((size_t)(br * 2 + dir) * T + t) * QK + h * DK + d; }
__device__ __forceinline__ size_t ab_index(int br, int dir, int b, int h, int n, int d) { return ((((size_t)(br * 2 + dir) * BATCH + b) * NH + h) * NCH + n) * DK + d; }
__device__ __forceinline__ void p2_prep(Frame& F, const Args& A) {
    const bf16* QKR = (const bf16*)(F.ws + WS_QKR); bf16* QT = (bf16*)(F.ws + WS_QT); bf16* KT = (bf16*)(F.ws + WS_KT);
    float* AL = (float*)(F.ws + WS_AL); float* BE = (float*)(F.ws + WS_BE); const float* GA = (const float*)(F.ws + WS_GA);
    const int* POS = (const int*)(const void*)A.in[IN_POS];
    LAS float* gaL = (LAS float*)F.lds;
    LAS float* totL = (LAS float*)(F.lds + 16384);
    LAS float* refL = (LAS float*)(F.lds + 16384 + 4096);
    const float scale = 0.08838834764831845f;
    for (int it_ = 0, item0 = blockIdx.x; item0 < 2 * BATCH * NH * NCH; item0 += F.G, ++it_) {
        const int item = (F.G == 256) ? ((((it_ >> 1) ^ ((int)blockIdx.x >> 3)) & 1) << 9) + (int)blockIdx.x + 256 * (it_ & 1) : item0;
        const int br = item >> 9, rem = item & 511, b = rem >> 6, h = (rem >> 4) & 3, n = rem & 15, t0 = b * SEQ + n * CH;
        if (br == 0) {
            const float lgf = log_sigmoid(A.in[IN_RDF][h]), lgb = log_sigmoid(A.in[IN_RDB][h]);
            const bf16* Q = QKR; const bf16* Kk = QKR + (size_t)T * QK;
#pragma unroll
            for (int i = 0; i < 2; ++i) {
                const int u = F.tid + 512 * i, j = u >> 3, g = u & 7, d0 = 8 * g, t = t0 + j;
                const float pos = (float)POS[t];
                const v4u q1 = *(const GAS v4u*)(Q + (size_t)t * QK + h * DK + d0), q2 = *(const GAS v4u*)(Q + (size_t)t * QK + h * DK + 64 + d0);
                const v4u k1 = *(const GAS v4u*)(Kk + (size_t)t * QK + h * DK + d0), k2 = *(const GAS v4u*)(Kk + (size_t)t * QK + h * DK + 64 + d0);
                const float af = (float)(j - 64) * lgf, ab = (float)(63 - j) * lgb;
                const float ef = fexp(af), eb = fexp(ab), efi = fexp(-af), ebi = fexp(-ab);
                float qa[8], qb[8], ka[8], kb[8];
#pragma unroll
                for (int x = 0; x < 8; ++x) {
                    const unsigned wq1 = q1[x >> 1], wq2 = q2[x >> 1], wk1 = k1[x >> 1], wk2 = k2[x >> 1];
                    const float a1 = (x & 1) ? bfhi(wq1) : bflo(wq1), a2 = (x & 1) ? bfhi(wq2) : bflo(wq2);
                    const float c1 = (x & 1) ? bfhi(wk1) : bflo(wk1), c2 = (x & 1) ? bfhi(wk2) : bflo(wk2);
                    const float invf = __builtin_amdgcn_exp2f(-(float)(d0 + x) * (13.287712379549449f / 64.0f));
                    const float ang = pos * invf; float rev = __builtin_amdgcn_fractf(ang * 0.15915494309189535f); const float sn = __builtin_amdgcn_sinf(rev), cs = __builtin_amdgcn_cosf(rev);
                    qa[x] = (a1 * cs - a2 * sn) * scale; qb[x] = (a2 * cs + a1 * sn) * scale;
                    ka[x] = c1 * cs - c2 * sn; kb[x] = c2 * cs + c1 * sn;
                }
                v4u o;
#define PK8(dst, arr, f) do { dst.x = pk2(arr[0] * (f), arr[1] * (f)); dst.y = pk2(arr[2] * (f), arr[3] * (f)); dst.z = pk2(arr[4] * (f), arr[5] * (f)); dst.w = pk2(arr[6] * (f), arr[7] * (f)); } while (0)
                PK8(o, qa, ef);  *(GAS v4u*)(QT + qt_index(0, 0, t, h, d0)) = o;
                PK8(o, qb, ef);  *(GAS v4u*)(QT + qt_index(0, 0, t, h, 64 + d0)) = o;
                PK8(o, qa, eb);  *(GAS v4u*)(QT + qt_index(0, 1, t, h, d0)) = o;
                PK8(o, qb, eb);  *(GAS v4u*)(QT + qt_index(0, 1, t, h, 64 + d0)) = o;
                PK8(o, ka, efi); *(GAS v4u*)(KT + qt_index(0, 0, t, h, d0)) = o;
                PK8(o, kb, efi); *(GAS v4u*)(KT + qt_index(0, 0, t, h, 64 + d0)) = o;
                PK8(o, ka, ebi); *(GAS v4u*)(KT + qt_index(0, 1, t, h, d0)) = o;
                PK8(o, kb, ebi); *(GAS v4u*)(KT + qt_index(0, 1, t, h, 64 + d0)) = o;
#undef PK8
            }
            if (F.tid < 128) { const int d = F.tid;
                AL[ab_index(0, 0, b, h, n, d)] = expf(63.f * lgf); BE[ab_index(0, 0, b, h, n, d)] = expf(65.f * lgf);
                AL[ab_index(0, 1, b, h, n, d)] = expf(63.f * lgb); BE[ab_index(0, 1, b, h, n, d)] = expf(65.f * lgb); }
        } else {
            __syncthreads();
            for (int i = F.tid; i < CH * 32 / 4; i += NTHR) ((LAS f32x4*)gaL)[i] = *(const GAS f32x4*)(GA + (size_t)t0 * 32 + (size_t)i * 4);
            __syncthreads();
            const int lane = F.lane, tok = lane & 15, g4 = lane >> 4, d0 = 16 * F.wave, dq = d0 + 4 * g4;
            const bf16* Q = QKR + (size_t)2 * T * QK; const bf16* Kk = QKR + (size_t)3 * T * QK;
            v2u qv[8], kv[8];
#pragma unroll
            for (int tt = 0; tt < 8; ++tt) { const size_t o = (size_t)(t0 + 16 * tt + tok) * QK + h * DK + dq; qv[tt] = *(const GAS v2u*)(Q + o); kv[tt] = *(const GAS v2u*)(Kk + o); }
#pragma unroll 1
            for (int dir = 0; dir < 2; ++dir) {
                const float* Wg = dir ? A.in[IN_GWB] : A.in[IN_GWF]; const float* Bg = dir ? A.in[IN_GBB] : A.in[IN_GBF];
                bf16x8 a1, a2;
                { float w[8];
#pragma unroll
                  for (int j = 0; j < 8; ++j) w[j] = Wg[(size_t)(8 * (g4 & 1) + j) * QK + h * DK + d0 + tok];
                  unsigned hh[8], ll[8];
#pragma unroll
                  for (int j = 0; j < 8; ++j) { hh[j] = f2bf(w[j]); ll[j] = f2bf(w[j] - bf2f(hh[j])); }
                  v4u hv, lv; hv.x = hh[0] | (hh[1] << 16); hv.y = hh[2] | (hh[3] << 16); hv.z = hh[4] | (hh[5] << 16); hv.w = hh[6] | (hh[7] << 16);
                  lv.x = ll[0] | (ll[1] << 16); lv.y = ll[2] | (ll[3] << 16); lv.z = ll[4] | (ll[5] << 16); lv.w = ll[6] | (ll[7] << 16);
                  if (g4 >= 2) lv = (v4u){0u, 0u, 0u, 0u};
                  a1 = __builtin_bit_cast(bf16x8, hv); a2 = __builtin_bit_cast(bf16x8, lv); }
                const f32x4 bias = *(const GAS f32x4*)(Bg + h * DK + dq);
                f32x4 la[8];
#pragma unroll
                for (int tt = 0; tt < 8; ++tt) {
                    const LAS float* gp = gaL + (16 * tt + tok) * 32 + dir * 16 + 8 * (g4 & 1);
                    const f32x4 g0 = *(const LAS f32x4*)gp, g1 = *(const LAS f32x4*)(gp + 4);
                    v4u gh; gh.x = pk2(g0.x, g0.y); gh.y = pk2(g0.z, g0.w); gh.z = pk2(g1.x, g1.y); gh.w = pk2(g1.z, g1.w);
                    v4u gl; gl.x = pk2(g0.x - bflo(gh.x), g0.y - bfhi(gh.x)); gl.y = pk2(g0.z - bflo(gh.y), g0.w - bfhi(gh.y));
                    gl.z = pk2(g1.x - bflo(gh.z), g1.y - bfhi(gh.z)); gl.w = pk2(g1.z - bflo(gh.w), g1.w - bfhi(gh.w));
                    const v4u z4 = {0u, 0u, 0u, 0u};
                    const bf16x8 b1 = __builtin_bit_cast(bf16x8, g4 < 2 ? gh : gl), b2 = __builtin_bit_cast(bf16x8, g4 < 2 ? gh : z4);
                    f32x4 z = {0.f, 0.f, 0.f, 0.f};
                    z = __builtin_amdgcn_mfma_f32_16x16x32_bf16(a1, b1, z, 0, 0, 0);
                    z = __builtin_amdgcn_mfma_f32_16x16x32_bf16(a2, b2, z, 0, 0, 0);
#pragma unroll
                    for (int r = 0; r < 4; ++r) la[tt][r] = fast_log_sigmoid(z[r] + bias[r]) * (1.0f / 16.0f);
                }
                f32x4 P[8]; f32x4 carry = {0.f, 0.f, 0.f, 0.f};
#pragma unroll
                for (int tt = 0; tt < 8; ++tt) {
                    f32x4 v = la[tt];
#pragma unroll
                    for (int o = 1; o < 16; o <<= 1) {
#pragma unroll
                        for (int r = 0; r < 4; ++r) { const float t = __shfl_up(v[r], o, 16); v[r] += (tok >= o) ? t : 0.f; } }
                    v += carry; P[tt] = v;
#pragma unroll
                    for (int r = 0; r < 4; ++r) carry[r] = __shfl(v[r], 15, 16);
                }
                const f32x4 all = carry;
                f32x4 ref;
                if (dir == 0) {
#pragma unroll
                    for (int r = 0; r < 4; ++r) ref[r] = __shfl(P[4][r], 0, 16);
                } else { const f32x4 s3 = all - P[3] + la[3];
#pragma unroll
                    for (int r = 0; r < 4; ++r) ref[r] = __shfl(s3[r], 15, 16); }
#pragma unroll
                for (int tt = 0; tt < 8; ++tt) {
                    const f32x4 av = dir ? (all - P[tt] + la[tt]) - ref : P[tt] - ref;
                    const int t = t0 + 16 * tt + tok;
                    const v2u qq = qv[tt], kk2 = kv[tt];
                    const float q0 = bflo(qq.x), q1 = bfhi(qq.x), q2 = bflo(qq.y), q3 = bfhi(qq.y), k0 = bflo(kk2.x), k1 = bfhi(kk2.x), k2 = bflo(kk2.y), k3 = bfhi(kk2.y);
                    const float e0 = fexp(av.x), e1 = fexp(av.y), e2 = fexp(av.z), e3 = fexp(av.w), i0 = fexp(-av.x), i1 = fexp(-av.y), i2 = fexp(-av.z), i3 = fexp(-av.w);
                    v2u oq, ok; oq.x = pk2(q0 * scale * e0, q1 * scale * e1); oq.y = pk2(q2 * scale * e2, q3 * scale * e3); ok.x = pk2(k0 * i0, k1 * i1); ok.y = pk2(k2 * i2, k3 * i3);
                    *(GAS v2u*)(QT + qt_index(1, dir, t, h, dq)) = oq; *(GAS v2u*)(KT + qt_index(1, dir, t, h, dq)) = ok;
                }
                if (tok == 0) { f32x4 al, be;
#pragma unroll
                    for (int r = 0; r < 4; ++r) { al[r] = fexp(all[r] - ref[r]); be[r] = fexp(ref[r]); }
                    *(GAS f32x4*)(AL + ab_index(1, dir, b, h, n, dq)) = al; *(GAS f32x4*)(BE + ab_index(1, dir, b, h, n, dq)) = be; }
            }
        }
    }
}

#define MFMA32(a, b, c) __builtin_amdgcn_mfma_f32_32x32x16_bf16((a), (b), (c), 0, 0, 0)
__device__ __forceinline__ bf16x8 frag_kcontig(const bf16* rowbase_k0, int hh) { return *(const GAS bf16x8*)(rowbase_k0 + 8 * hh); }
__device__ __forceinline__ bf16x8 frag_kstrided(const bf16* p, size_t pitch) {
    bf16x8 v;
#pragma unroll
    for (int jj = 0; jj < 8; ++jj) v[jj] = (short)((const GAS bf16*)p)[(size_t)jj * pitch];
    return v;
}

typedef short s16x4 __attribute__((ext_vector_type(4)));
typedef short v4i16_t __attribute__((ext_vector_type(4)));
__device__ __forceinline__ s16x4 vtr(LAS const unsigned char* p) { return __builtin_bit_cast(s16x4, __builtin_amdgcn_ds_read_tr16_b64_v4i16((LAS v4i16_t*)p)); }
__device__ __forceinline__ bf16x8 tr_frag(LAS const unsigned char* p, int pitch) { const s16x4 lo = vtr(p), hi = vtr(p + 4 * pitch); return __builtin_shufflevector(lo, hi, 0, 1, 2, 3, 4, 5, 6, 7); }
__device__ __forceinline__ bf16x8 sw_frag(LAS const unsigned char* tile, int row, int ks, int hh) { return *(const LAS bf16x8*)(tile + row * 256 + (((2 * ks + hh) ^ (row & 15)) << 4)); }

__device__ __forceinline__ size_t rt_index(int br, int dir, int b, int h, int n) { return ((((size_t)(br * 2 + dir) * BATCH + b) * NH + h) * NCH + n) * (size_t)(DV * DK); }
__device__ __forceinline__ void p3_scan(Frame& F, const Args& A) {
    const bf16* KT = (const bf16*)(F.ws + WS_KT); const bf16* V = (const bf16*)(F.ws + WS_V);
    const float* AL = (const float*)(F.ws + WS_AL); const float* BE = (const float*)(F.ws + WS_BE); bf16* RT = (bf16*)(F.ws + WS_RT);
    constexpr int TP = 320;
    LAS unsigned char* Kt = F.lds; LAS unsigned char* Vt = F.lds + 128 * TP;
    constexpr int SP = 272;
    LAS unsigned char* St = F.lds + 2 * 128 * TP;
    LAS float* ALt = (LAS float*)(F.lds + 2 * 128 * TP + 128 * SP);
    LAS float* BEt = (LAS float*)(F.lds + LDSCTL_OFF + 1024);
    static_assert(2 * 128 * TP + 128 * SP + 8192 <= 131072 && LDSCTL_OFF + 1024 + 8192 <= LDS_BYTES, "P3 LDS");
    const int lane = F.lane, r = lane & 31, hh = lane >> 5, blk = (lane >> 4) & 1, q = (lane & 15) >> 2, pp = lane & 3;
    for (int item = blockIdx.x; item < 256; item += F.G) {
        const int br = item >> 7, dir = (item >> 6) & 1, b = (item >> 3) & 7, h = (item >> 1) & 3, eh = item & 1;
        const int dblk = F.wave >> 1, ep = F.wave & 1;
        f32x16 S0, S1;
#pragma unroll
        for (int i = 0; i < 16; ++i) { S0[i] = 0.f; S1[i] = 0.f; }
        v4u preA[8], preB[8];
        int tidv = F.tid; asm volatile("" : "+v"(tidv));
#define P3_CH(st_) (((st_) < NCH ? (st_) : NCH - 1))
#define P3_N(st_) (dir ? NCH - 1 - P3_CH(st_) : P3_CH(st_))
#define P3_LOAD(st_, pre) do { const int t0_ = b * SEQ + P3_N(st_) * CH; _Pragma("unroll") for (int i = 0; i < 8; ++i) { const int c = tidv + 512 * i, tl = c >> 11, row = (c >> 4) & 127, ch = c & 15; \
            const bf16* src = tl ? (V + ((size_t)br * T + t0_ + row) * VD + h * DV + eh * 128 + 8 * ch) : (KT + qt_index(br, dir, t0_ + row, h, 8 * ch)); pre[i] = *(const GAS v4u*)src; } } while (0)
        P3_LOAD(0, preA); P3_LOAD(1, preB);
        __syncthreads();
        { const size_t abi = ab_index(br, dir, b, h, 0, 0);
          ((LAS f32x4*)ALt)[tidv] = *(const GAS f32x4*)(AL + abi + 4 * (size_t)tidv); ((LAS f32x4*)BEt)[tidv] = *(const GAS f32x4*)(BE + abi + 4 * (size_t)tidv); }
#define P3_STEP(st_, pre) do { const int n = P3_N(st_); \
            __syncthreads(); \
            _Pragma("unroll") for (int i = 0; i < 8; ++i) { const int c = tidv + 512 * i, tl = c >> 11, row = (c >> 4) & 127, ch = c & 15; \
                if (tl) *(LAS v4u*)(Vt + row * TP + ch * 16) = pre[i]; \
                else { const int cq = ch & 3, col0 = 32 * (ch >> 2) + 16 * (cq & 1) + 4 * (cq >> 1);     \
                    v2u lo2, hi2; lo2.x = pre[i].x; lo2.y = pre[i].y; hi2.x = pre[i].z; hi2.y = pre[i].w;    \
                    *(LAS v2u*)(Kt + row * TP + col0 * 2) = lo2; *(LAS v2u*)(Kt + row * TP + (col0 + 8) * 2) = hi2; } } \
              \
            { const LAS f32x4* bp = (const LAS f32x4*)(BEt + n * 128 + 32 * dblk + 16 * hh); \
              _Pragma("unroll") for (int g = 0; g < 4; ++g) { const f32x4 be = bp[g]; \
                  _Pragma("unroll") for (int x = 0; x < 4; ++x) { S0[4 * g + x] *= be[x]; S1[4 * g + x] *= be[x]; } } } \
            { LAS unsigned char* sp = St + (ep * 64 + r) * SP + 64 * dblk + 32 * hh;                   \
              v4u o; \
              o.x = pk2(S0[0], S0[1]); o.y = pk2(S0[2], S0[3]); o.z = pk2(S0[4], S0[5]); o.w = pk2(S0[6], S0[7]);         *(LAS v4u*)(sp) = o; \
              o.x = pk2(S0[8], S0[9]); o.y = pk2(S0[10], S0[11]); o.z = pk2(S0[12], S0[13]); o.w = pk2(S0[14], S0[15]);   *(LAS v4u*)(sp + 16) = o; \
              o.x = pk2(S1[0], S1[1]); o.y = pk2(S1[2], S1[3]); o.z = pk2(S1[4], S1[5]); o.w = pk2(S1[6], S1[7]);         *(LAS v4u*)(sp + 32 * SP) = o; \
              o.x = pk2(S1[8], S1[9]); o.y = pk2(S1[10], S1[11]); o.z = pk2(S1[12], S1[13]); o.w = pk2(S1[14], S1[15]);   *(LAS v4u*)(sp + 32 * SP + 16) = o; } \
            __syncthreads(); \
            P3_LOAD((st_) + 2, pre);                            \
            { bf16* rt = RT + rt_index(br, dir, b, h, n) + (size_t)(eh * 128) * DK; \
              _Pragma("unroll") for (int i = 0; i < 4; ++i) { const int c = tidv + 512 * i, row = c >> 4, ch = c & 15; \
                  *(GAS v4u*)(rt + (size_t)row * DK + 8 * ch) = *(const LAS v4u*)(St + row * SP + ch * 16); } } \
              \
            { const LAS unsigned char* ka = Kt + (8 * hh + q) * TP + (32 * dblk + 16 * blk + 4 * pp) * 2; \
              const LAS unsigned char* vb = Vt + (8 * hh + q) * TP + (ep * 64 + 16 * blk + 4 * pp) * 2; \
              _Pragma("unroll") for (int ks = 0; ks < 8; ++ks) { \
                const bf16x8 a = tr_frag(ka + ks * 16 * TP, TP); \
                const bf16x8 b0 = tr_frag(vb + ks * 16 * TP, TP), b1 = tr_frag(vb + 64 + ks * 16 * TP, TP); \
                S0 = MFMA32(a, b0, S0); S1 = MFMA32(a, b1, S1); } } \
            { const LAS f32x4* ap = (const LAS f32x4*)(ALt + n * 128 + 32 * dblk + 16 * hh); \
              _Pragma("unroll") for (int g = 0; g < 4; ++g) { const f32x4 al = ap[g]; \
                  _Pragma("unroll") for (int x = 0; x < 4; ++x) { S0[4 * g + x] *= al[x]; S1[4 * g + x] *= al[x]; } } } \
        } while (0)
#pragma unroll 1
        for (int step = 0; step < NCH; step += 2) { P3_STEP(step, preA); P3_STEP(step + 1, preB); }
#undef P3_STEP
#undef P3_LOAD
#undef P3_N
#undef P3_CH
    }
}

__device__ __forceinline__ void p4_chunk(Frame& F, const Args& A) {
    const bf16* QT = (const bf16*)(F.ws + WS_QT); const bf16* KT = (const bf16*)(F.ws + WS_KT); const bf16* V = (const bf16*)(F.ws + WS_V);
    const bf16* RT = (const bf16*)(F.ws + WS_RT); const bf16* Gt = (const bf16*)(F.ws + WS_G); bf16* RO = (bf16*)(F.ws + WS_RO);
    constexpr int VP = 576;
    constexpr int NITEM = 2 * BATCH * NH * NCH;
    LAS unsigned char* L = F.lds;
    LAS float* ST = (LAS float*)(F.lds + LDSCTL_OFF + 1024);
    const int ib = F.wave & 3, eh = F.wave >> 2;
    v4u pre1[8];
#define P4_LOAD1(it_, dst_, i0_) do { const int br_ = (it_) >> 9, rem_ = (it_) & 511, b_ = rem_ >> 6, h_ = (rem_ >> 4) & 3, n_ = rem_ & 15, t0_ = b_ * SEQ + n_ * CH; \
        int tv_ = F.tid; asm volatile("" : "+v"(tv_)); \
        _Pragma("unroll") for (int i = 0; i < 8; ++i) { const int c = tv_ + 512 * (i + (i0_)), tl = c >> 11, row = (c >> 4) & 127, ch = c & 15; \
            dst_[i] = *(const GAS v4u*)((tl < 2 ? KT : QT) + qt_index(br_, tl & 1, t0_ + row, h_, 8 * ch)); } } while (0)
    int item = blockIdx.x;
    P4_LOAD1(item < NITEM ? item : 0, pre1, 0);
    for (; item < NITEM; item += F.G) {
        const int br = item >> 9, rem = item & 511, b = rem >> 6, h = (rem >> 4) & 3, n = rem & 15, t0 = b * SEQ + n * CH;
        int tidv = F.tid; asm volatile("" : "+v"(tidv));
        const int lane = tidv & 63, r = lane & 31, hh = lane >> 5, blk = (lane >> 4) & 1, q = (lane & 15) >> 2, pp = lane & 3;
        __syncthreads();
        { v4u pre2[8]; P4_LOAD1(item, pre2, 8);
#pragma unroll
          for (int i = 0; i < 8; ++i) { const int c = tidv + 512 * i, tl = c >> 11, row = (c >> 4) & 127, ch = c & 15;
              *(LAS v4u*)(L + tl * 32768 + row * 256 + ((ch ^ (row & 15)) << 4)) = pre1[i]; }
#pragma unroll
          for (int i = 0; i < 8; ++i) { const int c = tidv + 512 * (i + 8), tl = c >> 11, row = (c >> 4) & 127, ch = c & 15;
              *(LAS v4u*)(L + tl * 32768 + row * 256 + ((ch ^ (row & 15)) << 4)) = pre2[i]; } }
        __syncthreads();
        const int rowq = 32 * ib + r;
        bf16x8 qf[8], qb[8];
#pragma unroll
        for (int ks = 0; ks < 8; ++ks) { qf[ks] = sw_frag(L + 2 * 32768, rowq, ks, hh); qb[ks] = sw_frag(L + 3 * 32768, rowq, ks, hh); }
        v4u preV[8];
#pragma unroll
        for (int i = 0; i < 8; ++i) { const int c = tidv + 512 * i, row = c >> 5, ch = c & 31; preV[i] = *(const GAS v4u*)(V + ((size_t)br * T + t0 + row) * VD + h * DV + 8 * ch); }
        v2u pk[2][4];
#pragma unroll
        for (int jj2 = 0; jj2 < 2; ++jj2) {
            const int jb = 2 * eh + jj2, rowk = 32 * jb + r;
            f32x16 sf, sb;
#pragma unroll
            for (int i = 0; i < 16; ++i) { sf[i] = 0.f; sb[i] = 0.f; }
            if (jb <= ib) {
#pragma unroll
                for (int ks = 0; ks < 8; ++ks) sf = MFMA32(sw_frag(L, rowk, ks, hh), qf[ks], sf); }
            if (jb >= ib) {
#pragma unroll
                for (int ks = 0; ks < 8; ++ks) sb = MFMA32(sw_frag(L + 32768, rowk, ks, hh), qb[ks], sb); }
#pragma unroll
            for (int g = 0; g < 4; ++g) {
                const int j0 = 32 * jb + 8 * g + 4 * hh;
                float pv[4];
#pragma unroll
                for (int x = 0; x < 4; ++x) pv[x] = (j0 + x <= rowq) ? sf[4 * g + x] : sb[4 * g + x];
                pk[jj2][g].x = pk2(pv[0], pv[1]); pk[jj2][g].y = pk2(pv[2], pv[3]);
            }
        }
        __syncthreads();
#pragma unroll
        for (int jj2 = 0; jj2 < 2; ++jj2)
#pragma unroll
            for (int g = 0; g < 4; ++g) { const int jb = 2 * eh + jj2; *(LAS v2u*)(L + rowq * 256 + (((4 * jb + g) ^ (rowq & 15)) << 4) + 8 * hh) = pk[jj2][g]; }
#pragma unroll
        for (int i = 0; i < 8; ++i) { const int c = tidv + 512 * i, row = c >> 5, ch = c & 31; *(LAS v4u*)(L + 32768 + row * VP + ch * 16) = preV[i]; }
        __syncthreads();
        f32x16 acc[4];
#pragma unroll
        for (int c = 0; c < 4; ++c)
#pragma unroll
            for (int i = 0; i < 16; ++i) acc[c][i] = 0.f;
        const int ebase = eh * 128;
        { const LAS unsigned char* va = L + 32768 + (8 * hh + q) * VP + (ebase + 16 * blk + 4 * pp) * 2;
#pragma unroll
          for (int ks = 0; ks < 8; ++ks) {
            const bf16x8 pb = sw_frag(L, rowq, ks, hh);
#pragma unroll
            for (int c = 0; c < 4; ++c) acc[c] = MFMA32(tr_frag(va + ks * 16 * VP + c * 64, VP), pb, acc[c]);
            __builtin_amdgcn_sched_barrier(0);
          } }
        __syncthreads();
        v4u preR[8];
#pragma unroll
        for (int i = 0; i < 8; ++i) { const int c = tidv + 512 * i, row = c >> 4, ch = c & 15; preR[i] = *(const GAS v4u*)(RT + rt_index(br, 0, b, h, n) + (size_t)row * DK + 8 * ch); }
#pragma unroll
        for (int i = 0; i < 8; ++i) { const int c = tidv + 512 * i, row = c >> 4, ch = c & 15; *(LAS v4u*)(L + row * 256 + ((ch ^ (row & 15)) << 4)) = preR[i]; }
#pragma unroll
        for (int i = 0; i < 8; ++i) { const int c = tidv + 512 * i, row = c >> 4, ch = c & 15; preR[i] = *(const GAS v4u*)(RT + rt_index(br, 1, b, h, n) + (size_t)row * DK + 8 * ch); }
        __syncthreads();
#pragma unroll
        for (int ks = 0; ks < 8; ++ks) {
#pragma unroll
            for (int c = 0; c < 4; ++c) acc[c] = MFMA32(sw_frag(L, ebase + 32 * c + r, ks, hh), qf[ks], acc[c]);
            __builtin_amdgcn_sched_barrier(0); }
#pragma unroll
        for (int i = 0; i < 8; ++i) { const int c = tidv + 512 * i, row = c >> 4, ch = c & 15; *(LAS v4u*)(L + 65536 + row * 256 + ((ch ^ (row & 15)) << 4)) = preR[i]; }
        v4u gtv[8];
#pragma unroll
        for (int i = 0; i < 8; ++i) { const int c = tidv + 512 * i, row = c >> 5, ch = c & 31; gtv[i] = *(const GAS v4u*)(Gt + ((size_t)br * T + t0 + row) * VD + h * DV + 8 * ch); }
        __syncthreads();
#pragma unroll
        for (int ks = 0; ks < 8; ++ks) {
#pragma unroll
            for (int c = 0; c < 4; ++c) acc[c] = MFMA32(sw_frag(L + 65536, ebase + 32 * c + r, ks, hh), qb[ks], acc[c]);
            __builtin_amdgcn_sched_barrier(0); }
        float s1 = 0.f, s2 = 0.f;
#pragma unroll
        for (int c = 0; c < 4; ++c)
#pragma unroll
            for (int i = 0; i < 16; ++i) { s1 += acc[c][i]; s2 += acc[c][i] * acc[c][i]; }
        s1 += __shfl_xor(s1, 32); s2 += __shfl_xor(s2, 32);
        if (hh == 0) { ST[((ib * 2 + eh) * 32 + r) * 2] = s1; ST[((ib * 2 + eh) * 32 + r) * 2 + 1] = s2; }
        __syncthreads();
        const float o1 = ST[((ib * 2 + (eh ^ 1)) * 32 + r) * 2], o2 = ST[((ib * 2 + (eh ^ 1)) * 32 + r) * 2 + 1];
        s1 += o1; s2 += o2;
        float mu, rstd;
        if (br == 0) { mu = s1 * (1.f / DV); const float var = fmaxf(s2 * (1.f / DV) - mu * mu, 0.f); rstd = 1.f / sqrtf(var + EPS); }
        else         { mu = 0.f; rstd = 1.f / sqrtf(s2 * (1.f / DV) + EPS); }
        const float* nw = (br == 0 ? A.in[IN_RET_NORM] : A.in[IN_GLA_NORM]) + h * DV;
#pragma unroll
        for (int c = 0; c < 4; ++c)
#pragma unroll
            for (int g = 0; g < 4; ++g) {
                const int e = ebase + 32 * c + 8 * g + 4 * hh;
                const f32x4 w = *(const GAS f32x4*)(nw + e);
                v2u o; o.x = pk2((acc[c][4 * g] - mu) * rstd * w.x, (acc[c][4 * g + 1] - mu) * rstd * w.y); o.y = pk2((acc[c][4 * g + 2] - mu) * rstd * w.z, (acc[c][4 * g + 3] - mu) * rstd * w.w);
                *(LAS v2u*)(L + rowq * 512 + ((((e >> 3)) ^ (rowq & 15)) << 4) + (e & 4) * 2) = o;
            }
        __syncthreads();
        { const int nx_ = item + (int)F.G; P4_LOAD1(nx_ < NITEM ? nx_ : item, pre1, 0); }
        {
#pragma unroll
          for (int i = 0; i < 8; ++i) { const int c = tidv + 512 * i, row = c >> 5, ch = c & 31;
            const v4u y = *(const LAS v4u*)(L + row * 512 + ((ch ^ (row & 15)) << 4));
            const size_t go = ((size_t)br * T + t0 + row) * VD + h * DV + 8 * ch;
            const v4u gt = gtv[i];
            v4u o; o.x = pk2(bflo(y.x) * bflo(gt.x), bfhi(y.x) * bfhi(gt.x)); o.y = pk2(bflo(y.y) * bflo(gt.y), bfhi(y.y) * bfhi(gt.y));
            o.z = pk2(bflo(y.z) * bflo(gt.z), bfhi(y.z) * bfhi(gt.z)); o.w = pk2(bflo(y.w) * bflo(gt.w), bfhi(y.w) * bfhi(gt.w));
            *(GAS v4u*)(RO + go) = o; } }
    }
#undef P4_LOAD1
}

__device__ __forceinline__ void p7_router(Frame& F, const Args& A) {
    LAS unsigned char* WH = F.lds;
    LAS unsigned char* WL = F.lds + 32768;
    LAS float* GL = (LAS float*)(F.lds + 65536);
    LAS float* ssX = (LAS float*)(F.lds + 69632);
    LAS f32x4* lgX = (LAS f32x4*)(F.lds + 69632 + 512);
    { const float* wr = A.in[IN_W_ROUTER]; const float* gn = A.in[IN_NORM_FFN];
#pragma unroll
      for (int i = 0; i < 4; ++i) { const int x = F.tid + 512 * i, e = x & 15, kg = (x >> 4) & 3, S = x >> 6, k0 = 32 * S + 8 * kg;
          float w[8];
#pragma unroll
          for (int j = 0; j < 8; ++j) w[j] = wr[(size_t)(k0 + j) * NE + e] * gn[k0 + j];
          unsigned h[8], l[8];
#pragma unroll
          for (int j = 0; j < 8; ++j) { h[j] = f2bf(w[j]); l[j] = f2bf(w[j] - bf2f(h[j])); }
          v4u hv, lv; hv.x = h[0] | (h[1] << 16); hv.y = h[2] | (h[3] << 16); hv.z = h[4] | (h[5] << 16); hv.w = h[6] | (h[7] << 16);
          lv.x = l[0] | (l[1] << 16); lv.y = l[2] | (l[3] << 16); lv.z = l[4] | (l[5] << 16); lv.w = l[6] | (l[7] << 16);
          *(LAS v4u*)(WH + x * 16) = hv; *(LAS v4u*)(WL + x * 16) = lv; }
      if (F.tid < 256) *((LAS f32x4*)GL + F.tid) = *((const GAS f32x4*)gn + F.tid); }
    __syncthreads();
    unsigned char* H2 = (unsigned char*)(F.ws + WS_H2); float* AFF = (float*)(F.ws + WS_AFF);
    static_assert(MOE_FP8 == 1, "P7 writes fp8 rows");
    const int lane = F.lane, tok = lane & 15, kg = lane >> 4, kh = F.wave & 1;
    for (int tile0 = F.vcu * 4; tile0 < T / 16; tile0 += 4 * F.G) {
        const int m = 16 * (tile0 + (F.wave >> 1)) + tok;
        const GAS f32x4* xr = (const GAS f32x4*)(F.out + (size_t)m * D + kh * 512 + 8 * kg);
        f32x4 v[32];
#pragma unroll
        for (int s2 = 0; s2 < 16; ++s2) { v[2 * s2] = xr[8 * s2]; v[2 * s2 + 1] = xr[8 * s2 + 1]; }
        f32x4 acc = {0.f, 0.f, 0.f, 0.f}; float ss = 0.f;
        LAS const unsigned char* whp = WH + ((kh * 16 * 4 + kg) * 16 + tok) * 16; LAS const unsigned char* wlp = WL + ((kh * 16 * 4 + kg) * 16 + tok) * 16;
        asm volatile("" : "+v"(whp), "+v"(wlp));
#pragma unroll
        for (int s2 = 0; s2 < 16; ++s2) {
            const f32x4 a = v[2 * s2], c = v[2 * s2 + 1];
            ss += (a.x * a.x + a.y * a.y) + (a.z * a.z + a.w * a.w) + (c.x * c.x + c.y * c.y) + (c.z * c.z + c.w * c.w);
            v4u xh; xh.x = pk2(a.x, a.y); xh.y = pk2(a.z, a.w); xh.z = pk2(c.x, c.y); xh.w = pk2(c.z, c.w);
            v4u xl; xl.x = pk2(a.x - bflo(xh.x), a.y - bfhi(xh.x)); xl.y = pk2(a.z - bflo(xh.y), a.w - bfhi(xh.y));
            xl.z = pk2(c.x - bflo(xh.z), c.y - bfhi(xh.z)); xl.w = pk2(c.z - bflo(xh.w), c.w - bfhi(xh.w));
            const bf16x8 wh = *(const LAS bf16x8*)(whp + s2 * 1024), wl = *(const LAS bf16x8*)(wlp + s2 * 1024);
            const bf16x8 bh = __builtin_bit_cast(bf16x8, xh), bl = __builtin_bit_cast(bf16x8, xl);
            acc = __builtin_amdgcn_mfma_f32_16x16x32_bf16(wh, bh, acc, 0, 0, 0);
            acc = __builtin_amdgcn_mfma_f32_16x16x32_bf16(wh, bl, acc, 0, 0, 0);
            acc = __builtin_amdgcn_mfma_f32_16x16x32_bf16(wl, bh, acc, 0, 0, 0);
            if ((s2 & 3) == 3) __builtin_amdgcn_sched_barrier(0);
        }
        ss += __shfl_xor(ss, 16); ss += __shfl_xor(ss, 32);
        __syncthreads();
        if (kg == 0) ssX[F.wave * 16 + tok] = ss;
        lgX[F.wave * 64 + lane] = acc;
        __syncthreads();
        const float rstd = 1.f / sqrtf((ss + ssX[(F.wave ^ 1) * 16 + tok]) * (1.f / D) + EPS);
        { GAS v2u* o8 = (GAS v2u*)(H2 + (size_t)m * D + kh * 512 + 8 * kg); LAS const f32x4* gp = (LAS const f32x4*)(GL + kh * 512 + 8 * kg);
          const float sc = rstd * SC_H;
#pragma unroll
          for (int s2 = 0; s2 < 16; ++s2) { const f32x4 g0 = gp[8 * s2], g1 = gp[8 * s2 + 1]; const f32x4 a = v[2 * s2], c = v[2 * s2 + 1];
              v2u o; o.x = pk4_fp8(a.x * sc * g0.x, a.y * sc * g0.y, a.z * sc * g0.z, a.w * sc * g0.w); o.y = pk4_fp8(c.x * sc * g1.x, c.y * sc * g1.y, c.z * sc * g1.z, c.w * sc * g1.w);
              o8[4 * s2] = o; } }
        if (kh == 0) {
            const f32x4 o = lgX[(F.wave ^ 1) * 64 + lane];
            f32x4 lg; lg.x = (acc.x + o.x) * rstd; lg.y = (acc.y + o.y) * rstd; lg.z = (acc.z + o.z) * rstd; lg.w = (acc.w + o.w) * rstd;
            float mx = fmaxf(fmaxf(lg.x, lg.y), fmaxf(lg.z, lg.w)); mx = fmaxf(mx, __shfl_xor(mx, 16)); mx = fmaxf(mx, __shfl_xor(mx, 32));
            f32x4 ex; ex.x = expf(lg.x - mx); ex.y = expf(lg.y - mx); ex.z = expf(lg.z - mx); ex.w = expf(lg.w - mx);
            float sum = (ex.x + ex.y) + (ex.z + ex.w); sum += __shfl_xor(sum, 16); sum += __shfl_xor(sum, 32);
            const float inv = 1.f / sum; const int b = m >> 11, sidx = m & (SEQ - 1);
            float* ap = AFF + ((size_t)b * NE + 4 * kg) * SEQ + sidx;
            ap[0] = ex.x * inv; ap[SEQ] = ex.y * inv; ap[2 * SEQ] = ex.z * inv; ap[3 * SEQ] = ex.w * inv;
        }
    }
}

__device__ __forceinline__ int block_excl_scan(int v, LAS int* wsum, int wave, int lane, int& total) {
    int inc = v;
#pragma unroll
    for (int o = 1; o < 64; o <<= 1) { const int t = __shfl_up(inc, o); if (lane >= o) inc += t; }
    __syncthreads();
    if (lane == 63) wsum[wave] = inc;
    __syncthreads();
    int off = 0, tot = 0;
#pragma unroll
    for (int w = 0; w < NWAVES; ++w) { const int x = wsum[w]; off += (w < wave) ? x : 0; tot += x; }
    total = tot; return off + inc - v;
}
__device__ __forceinline__ void p8_topk(Frame& F, const Args& A) {
    const float* AFF = (const float*)(F.ws + WS_AFF); int* RK = (int*)(F.ws + WS_RK); float* GATEV = (float*)(F.ws + WS_GATEV);
    const bf16* H2 = (const bf16*)(F.ws + WS_H2); bf16* XG = (bf16*)(F.ws + WS_XG);
    LAS int* sel = (LAS int*)(F.lds + 69632);
    LAS int* cntL = (LAS int*)(F.lds + 69632 + 1024);
    LAS int* wsum = (LAS int*)(F.lds + 69632 + 2048);
    for (int item2 = blockIdx.x; item2 < 2 * BATCH * NE; item2 += F.G) {
        const int item = item2 & (BATCH * NE - 1), half = item2 >> 7;
        const int b = item >> 4, e = item & 15;
        __syncthreads();
        if (F.tid < 64) cntL[F.tid] = 0;
        const v4u k4 = *(const GAS v4u*)(AFF + ((size_t)b * NE + e) * SEQ + 4 * F.tid);
        const unsigned kk[4] = {k4.x, k4.y, k4.z, k4.w};
        __syncthreads();
        unsigned lo = 0u, hi = 0x3F800001u; int it = 0;
        while (hi - lo > 1u) {
            const unsigned q = (hi - lo + 3u) >> 2;
            const unsigned m1 = lo + q, m2 = (lo + 2u * q < hi) ? lo + 2u * q : hi, m3 = (lo + 3u * q < hi) ? lo + 3u * q : hi;
            const int c1 = __popcll(__ballot(k4.x >= m1)) + __popcll(__ballot(k4.y >= m1)) + __popcll(__ballot(k4.z >= m1)) + __popcll(__ballot(k4.w >= m1));
            const int c2 = __popcll(__ballot(k4.x >= m2)) + __popcll(__ballot(k4.y >= m2)) + __popcll(__ballot(k4.z >= m2)) + __popcll(__ballot(k4.w >= m2));
            const int c3 = __popcll(__ballot(k4.x >= m3)) + __popcll(__ballot(k4.y >= m3)) + __popcll(__ballot(k4.z >= m3)) + __popcll(__ballot(k4.w >= m3));
            if (F.lane < 3) __hip_atomic_fetch_add(&cntL[3 * it + F.lane], F.lane == 0 ? c1 : (F.lane == 1 ? c2 : c3), __ATOMIC_RELAXED, __HIP_MEMORY_SCOPE_WORKGROUP);
            __syncthreads();
            const int t1 = cntL[3 * it], t2 = cntL[3 * it + 1], t3 = cntL[3 * it + 2];
            if (t3 >= CAP) lo = m3; else if (t2 >= CAP) { lo = m2; hi = m3; } else if (t1 >= CAP) { lo = m1; hi = m2; } else hi = m1;
            ++it;
        }
        const unsigned thr = lo;
        int ngt_tot, eq_tot;
        const int ngt = (k4.x > thr) + (k4.y > thr) + (k4.z > thr) + (k4.w > thr);
        const int neq = (k4.x == thr) + (k4.y == thr) + (k4.z == thr) + (k4.w == thr);
        (void)block_excl_scan(ngt, wsum, F.wave, F.lane, ngt_tot);
        int eqpre = block_excl_scan(neq, wsum, F.wave, F.lane, eq_tot);
        const int need = CAP - ngt_tot;
        int f[4]; int nsel = 0;
#pragma unroll
        for (int x = 0; x < 4; ++x) { const unsigned k = kk[x]; const bool iseq = (k == thr); f[x] = (k > thr) || (iseq && eqpre < need); eqpre += iseq ? 1 : 0; nsel += f[x]; }
        int sel_tot; int slot = block_excl_scan(nsel, wsum, F.wave, F.lane, sel_tot);
#pragma unroll
        for (int x = 0; x < 4; ++x) { const int i = 4 * F.tid + x;
            if (half == 0) RK[((size_t)b * SEQ + i) * NE + e] = f[x] ? slot : 0x7fffffff;
            if (f[x]) { sel[slot] = i; if (half == 0) GATEV[(size_t)e * EROWS + b * CAP + slot] = __builtin_bit_cast(float, kk[x]); ++slot; } }
        __syncthreads();
        constexpr int RB = MOE_FP8 ? D : 2 * D, CPR = RB / 16, LCPR = MOE_FP8 ? 6 : 7;
        for (int c0 = half * (CAP / 2) * CPR; c0 < (half + 1) * (CAP / 2) * CPR; c0 += NTHR * 8) {
            v4u tmp[8];
#pragma unroll
            for (int u = 0; u < 8; ++u) { const int c = c0 + u * NTHR + F.tid, sl = c >> LCPR, ch = c & (CPR - 1); tmp[u] = *((const GAS v4u*)((const unsigned char*)H2 + ((size_t)b * SEQ + sel[sl]) * RB) + ch); }
#pragma unroll
            for (int u = 0; u < 8; ++u) { const int c = c0 + u * NTHR + F.tid, sl = c >> LCPR, ch = c & (CPR - 1); *((GAS v4u*)((unsigned char*)XG + ((size_t)e * EROWS + b * CAP + sl) * RB) + ch) = tmp[u]; }
        }
    }
    const int gw = F.vcu * NWAVES + F.wave, NGW = F.G * NWAVES;
    if (F.G == 256) {
        unsigned base = __hip_atomic_load((gu32*)(F.ws + WS_CTL) + CW_CONVQ, RLX_AGENT); base = __builtin_amdgcn_readfirstlane(base);
        if (base > (unsigned)Q_P1) base = (unsigned)Q_P1;
        if (base < (unsigned)Q_N) y_range(F, A, (int)base + gw, Q_N, NGW);
    }
}

__device__ __forceinline__ void p11_final(Frame& F, const Args& A) {
    const int gw = F.vcu * NWAVES + F.wave, NGW = F.G * NWAVES, lane = F.lane;
    const int* RK = (const int*)(F.ws + WS_RK); const bf16* Y = (const bf16*)(F.ws + WS_Y);
    f32x4 gn[4];
#pragma unroll
    for (int j = 0; j < 4; ++j) gn[j] = *((const GAS f32x4*)A.in[IN_NORM_FINAL] + lane + 64 * j);
    int rkn = (gw < T && lane < NE) ? RK[(size_t)gw * NE + lane] : 0x7fffffff;
    for (int m = gw; m < T; m += NGW) {
        GAS f32x4* xr = (GAS f32x4*)(F.out + (size_t)m * D) + lane;
        GAS f32x4* xw = A.dup ? (GAS f32x4*)((float*)(F.ws + WS_R1) + (size_t)m * D) + lane : xr;
        f32x4 v[4];
#pragma unroll
        for (int j = 0; j < 4; ++j) v[j] = xr[64 * j];
        const int rkv = rkn;
        { const int mn = m + NGW; rkn = (mn < T && lane < NE) ? RK[(size_t)mn * NE + lane] : 0x7fffffff; }
        const int b = m >> 11;
        unsigned long long mask = __ballot(rkv < CAP);
        while (mask) {
            const int e0 = __builtin_ctzll(mask); mask &= mask - 1;
            const bool two = mask != 0ull; const int e1 = two ? __builtin_ctzll(mask) : e0; if (two) mask &= mask - 1;
            const int r0 = __builtin_amdgcn_readlane(rkv, e0), r1 = __builtin_amdgcn_readlane(rkv, e1);
            const GAS v2u* y0 = (const GAS v2u*)(Y + ((size_t)e0 * EROWS + b * CAP + r0) * D) + lane;
            const GAS v2u* y1 = (const GAS v2u*)(Y + ((size_t)e1 * EROWS + b * CAP + r1) * D) + lane;
            v2u w0[4], w1[4];
#pragma unroll
            for (int j = 0; j < 4; ++j) { w0[j] = y0[64 * j]; w1[j] = y1[64 * j]; }
            const float s1 = two ? 1.f : 0.f;
#pragma unroll
            for (int j = 0; j < 4; ++j) { v[j].x += bflo(w0[j].x) + s1 * bflo(w1[j].x); v[j].y += bfhi(w0[j].x) + s1 * bfhi(w1[j].x); v[j].z += bflo(w0[j].y) + s1 * bflo(w1[j].y); v[j].w += bfhi(w0[j].y) + s1 * bfhi(w1[j].y); }
        }
        float s = 0.f;
#pragma unroll
        for (int j = 0; j < 4; ++j) s += (v[j].x * v[j].x + v[j].y * v[j].y) + (v[j].z * v[j].z + v[j].w * v[j].w);
        const float rstd = 1.f / sqrtf(wave_sum(s) * (1.f / D) + EPS);
#pragma unroll
        for (int j = 0; j < 4; ++j) xw[64 * j] = v[j] * rstd * gn[j];
    }
}

__global__ void __launch_bounds__(NTHR, 2) mega_fwd(Args args) {
    extern __shared__ __attribute__((aligned(16))) unsigned char lds[];
    Frame F;
    F.lds = (LAS unsigned char*)lds;
    F.tid = threadIdx.x; F.lane = F.tid & 63; F.wave = __builtin_amdgcn_readfirstlane(F.tid >> 6);
    F.G = args.grid; { const int bx = blockIdx.x; F.vcu = (F.G % 8 == 0) ? (bx % 8) * (F.G / 8) + bx / 8 : bx; }
    F.out = args.out; F.ws = args.ws;
    volatile LAS unsigned* MISC = (volatile LAS unsigned*)(F.lds + MISC_OFF);
    for (int u = F.tid; u < (LDS_BYTES - LDSCTL_OFF) / 4; u += NTHR) ((LAS unsigned*)(F.lds + LDSCTL_OFF))[u] = 0u;
    __syncthreads();
    const int lo = args.ph_lo, hi = args.ph_hi;
    XcdBarrier bar; bar.bar = (unsigned*)(F.ws + WS_CTL) + CW_BAR; bar.x = 0; bar.st = nullptr; bar.G = 0; bar.wave = F.wave;
    if (hi - lo > 1) bar = xcd_barrier_post((unsigned*)(F.ws + WS_CTL) + CW_BAR, MISC + 8, F.wave);
#define IN(k) (lo <= (k) && (k) < hi)
#define SEAM(k) do { if (IN(k) && IN((k) + 1)) xcd_barrier(bar, (unsigned)args.grid); } while (0)

#define REFRAME() do { F.lane = lane_id_now(); F.tid = F.wave * 64 + F.lane; } while (0)
    if (IN(0)) { REFRAME(); p0_prologue(F, args); } SEAM(0);
    if (IN(1)) {
        const bool split = (F.G == 256); const int ng = split ? NG1 : F.G;
        if ((int)blockIdx.x < ng) {
            SchedPlain S{T / 256, DINP / 256, ng, (int)blockIdx.x, (const bf16*)(F.ws + WS_XN), (const bf16*)(F.ws + WS_WIN), split ? (gu32*)(F.ws + WS_CTL) + CW_DONE : (gu32*)nullptr};
            EpiInProj E{(bf16*)(F.ws + WS_QKR), (bf16*)(F.ws + WS_V), (bf16*)(F.ws + WS_G), (bf16*)F.out, (float*)(F.ws + WS_GA)};
            pg8::gemm_phase<D, EpiInProj, SchedPlain, true, true>(F.lds, S, E, F.wave);
        }
        if (split) { REFRAME(); p1_stream(F, args); }
    } SEAM(1);
    if (IN(2)) { REFRAME(); p2_prep(F, args); } SEAM(2);
    if (IN(3)) { REFRAME(); p3_scan(F, args); } SEAM(3);
    if (IN(4)) { REFRAME(); p4_chunk(F, args); } SEAM(4);
    if (IN(5)) {
        SchedBranch S{F.G, (int)blockIdx.x, (const bf16*)(F.ws + WS_RO), (const bf16*)(F.ws + WS_RO) + (size_t)T * VD, (const bf16*)(F.ws + WS_WBR), (const bf16*)(F.ws + WS_WBG)};
        EpiBranch E{(const bf16*)F.out, (bf16*)(F.ws + WS_MERGED)};
        pg8::gemm_phase<D, EpiBranch, SchedBranch, true, true>(F.lds, S, E, F.wave);
    } SEAM(5);
    if (IN(6)) {
        SchedPlain S{T / 256, D / 256, F.G, (int)blockIdx.x, (const bf16*)(F.ws + WS_MERGED), (const bf16*)(F.ws + WS_WOUT), (gu32*)nullptr};
        EpiOut E{args.in[IN_X], F.out};
        pg8::gemm_phase<D, EpiOut, SchedPlain, true, true>(F.lds, S, E, F.wave);
    } SEAM(6);
    if (IN(7)) { REFRAME(); p7_router(F, args); } SEAM(7);
    if (IN(8)) { REFRAME(); p8_topk(F, args); } SEAM(8);
    if (IN(9)) {
        SchedMoe S{2 * DFF / 256, F.G, (int)blockIdx.x, (const bf16*)(F.ws + WS_XG), (const bf16*)(F.ws + WS_WGU)};
        EpiSwiGLU E{(bf16*)(F.ws + WS_ACT)};
        pg8::gemm_phase<(MOE_FP8 ? D / 2 : D), EpiSwiGLU, SchedMoe, true, true, MOE_FP8 != 0>(F.lds, S, E, F.wave);
    } SEAM(9);
    if (IN(10)) {
        SchedMoe S{D / 256, F.G, (int)blockIdx.x, (const bf16*)(F.ws + WS_ACT), (const bf16*)(F.ws + WS_WDN)};
        EpiDown E{(const float*)(F.ws + WS_GATEV), (bf16*)(F.ws + WS_Y)};
        pg8::gemm_phase<(MOE_FP8 ? DFF / 2 : DFF), EpiDown, SchedMoe, true, true, MOE_FP8 != 0>(F.lds, S, E, F.wave);
    } SEAM(10);
    if (IN(11)) { REFRAME(); p11_final(F, args); }
#undef REFRAME
#undef IN
#undef SEAM
}

extern "C" void kernel_launch(void* const* d_in, const int* in_sizes, int n_in, void* d_out, int out_size, void* d_ws, size_t ws_size, hipStream_t stream) {
    static int grid = 0;
    if (grid == 0) {
        if (n_in != 21 || in_sizes[0] != T * D || out_size != T * D || ws_size < WS_END) {
            fprintf(stderr, "kernel_launch: shape/workspace mismatch: n_in %d in0 %d out %d ws %zu (need %zu); nothing launched\n", n_in, n_in > 0 ? in_sizes[0] : -1, out_size, ws_size, (size_t)WS_END); grid = -1; return; }
        int dev = 0, cus = 0, per_cu = 0;
        if (hipGetDevice(&dev) != hipSuccess || hipDeviceGetAttribute(&cus, hipDeviceAttributeMultiprocessorCount, dev) != hipSuccess) { grid = -1; return; }
        if (hipFuncSetAttribute((const void*)mega_fwd, hipFuncAttributeMaxDynamicSharedMemorySize, LDS_BYTES) != hipSuccess) { fprintf(stderr, "kernel_launch: hipFuncSetAttribute failed\n"); grid = -1; return; }
        if (hipOccupancyMaxActiveBlocksPerMultiprocessor(&per_cu, (const void*)mega_fwd, NTHR, LDS_BYTES) != hipSuccess || per_cu < 1) {
            fprintf(stderr, "kernel_launch: occupancy query reports %d workgroups per CU\n", per_cu); per_cu = 1; }
        (void)hipGetLastError();
        grid = cus;
        fprintf(stderr, "kernel_launch: grid %d (cus %d, occupancy %d/CU), ws %zu\n", grid, cus, per_cu, ws_size);
    }
    if (grid < 0) return;
    if (hipMemsetAsync((char*)d_ws + WS_CTL, 0, CTL_ZERO_BYTES, stream) != hipSuccess) { fprintf(stderr, "kernel_launch: memset failed\n"); return; }
    Args a{};
    for (int i = 0; i < 21; ++i) a.in[i] = (const float*)d_in[i];
    a.out = (float*)d_out; a.ws = (unsigned char*)d_ws; a.grid = grid;
    if (MK_N_LAUNCHES == 1) {
        a.ph_lo = 0; a.ph_hi = NPHASE;
        hipLaunchKernelGGL(mega_fwd, dim3(grid), dim3(NTHR), LDS_BYTES, stream, a);
    } else {
        for (int p = 0; p < NPHASE; ++p) { const int reps = ((PROBE_MASK >> p) & 1) ? 2 : 1;
            for (int rp = 0; rp < reps; ++rp) { a.ph_lo = p; a.ph_hi = p + 1; a.dup = (p == 11) ? (reps - 1 - rp) : rp; hipLaunchKernelGGL(mega_fwd, dim3(grid), dim3(NTHR), LDS_BYTES, stream, a); } }
    }
    const hipError_t le = hipPeekAtLastError();
    if (le != hipSuccess) fprintf(stderr, "kernel_launch: launch failed: %s\n", hipGetErrorName(le));
}
```

```cpp
#include <hip/hip_runtime.h>
#include <cstdio>
#include <cstdint>

#ifndef MK_N_LAUNCHES
#define MK_N_LAUNCHES 1
#endif

#ifndef MOE_FP8
#define MOE_FP8 1
#endif
#ifndef PROBE_MASK
#define PROBE_MASK 0x0
#endif
#define GAS __attribute__((address_space(1)))
#define LAS __attribute__((address_space(3)))

__device__ __forceinline__ int lane_id_now() { int l_; asm volatile("v_mbcnt_lo_u32_b32 %0, -1, 0\n\tv_mbcnt_hi_u32_b32 %0, -1, %0" : "=v"(l_)); return l_; }
namespace pg8 {
#define PG8_LAS __attribute__((address_space(3)))
typedef unsigned short bf16_t;
typedef short bf16x8 __attribute__((ext_vector_type(8)));
typedef float f32x4 __attribute__((ext_vector_type(4)));
typedef unsigned u32x4 __attribute__((ext_vector_type(4)));
typedef unsigned u32x2 __attribute__((ext_vector_type(2)));
typedef int i32x8 __attribute__((ext_vector_type(8)));
typedef int i32x4 __attribute__((ext_vector_type(4)));
constexpr int BM = 256, BK = 64, HALF = 128, HTB = HALF * BK * 2, STAGE_BYTES = 8 * HTB, NXCD = 8, WGM = 4;

__host__ __device__ __forceinline__ int lds_byte(int r, int c) { const int st = (r >> 4) * 2 + (c >> 5), rr = r & 15, cc = c & 31, ob = rr * 64 + cc * 2; return st * 1024 + (ob ^ (((ob >> 9) & 1) << 5)); }
__host__ __device__ __forceinline__ void stage_rc(int b, int& R, int& C) { const int st = b / 1024, sb = b % 1024, swz = sb ^ (((sb >> 9) & 1) << 5); R = (st >> 1) * 16 + swz / 64; C = (st & 1) * 32 + (swz % 64) / 2; }
__host__ __device__ __forceinline__ int perm32(int rho) { const int n = rho >> 4, i = rho & 15; return 8 * (i >> 2) + 4 * n + (i & 3); }

struct Unit { int pm, pn, aux; };

__device__ __forceinline__ void tile_of(int L, int nM, int nN, int& pm, int& pn) {
    const int nwg = nM * nN; int wgid = L;
    { const int q = nwg / NXCD, r = nwg % NXCD, xcd = wgid % NXCD, off = wgid / NXCD; wgid = (xcd < r ? xcd * (q + 1) : r * (q + 1) + (xcd - r) * q) + off; }
    const int nig = WGM * nN, gid = wgid / nig, fm = gid * WGM, gsz = (nM - fm) < WGM ? (nM - fm) : WGM;
    pm = fm + ((wgid % nig) % gsz); pn = (wgid % nig) / gsz;
}

__device__ __forceinline__ const char* uni(const char* p) { const unsigned long long v = (unsigned long long)p; const unsigned lo = __builtin_amdgcn_readfirstlane((unsigned)v), hi = __builtin_amdgcn_readfirstlane((unsigned)(v >> 32)); return (const char*)(((unsigned long long)hi << 32) | lo); }
__device__ __forceinline__ unsigned cvt_pk_bf16(float lo, float hi) { unsigned r; asm volatile("v_cvt_pk_bf16_f32 %0, %1, %2" : "=v"(r) : "v"(lo), "v"(hi)); return r; }

template <int K, class Epi, class Sched, bool ALIGN_EPI, bool SP2, bool FP8 = false>
__device__ __forceinline__ void gemm_phase(PG8_LAS unsigned char* lds, const Sched& S, const Epi& E, const int wid) {
    const int lane = lane_id_now(), tid = wid * 64 + lane, wr = wid >> 2, wc = wid & 3, fr = lane & 15, fq = lane >> 4;
    constexpr int nt = K / BK;
    unsigned voffA, voffB;
    { int R, C; stage_rc(tid * 16, R, C); const int Rb = Epi::PERM ? ((R & ~31) + perm32(R & 31)) : R;
        voffA = (unsigned)(R * K + C) * 2u; voffB = (unsigned)(Rb * K + C) * 2u; }
    constexpr size_t pstep = (size_t)64 * K * 2;
    constexpr size_t kstep = (size_t)(BK * 2);
    constexpr size_t hstep = (size_t)HALF * K * 2;
    constexpr size_t tstep = 2 * hstep;
    const unsigned ldsw = (unsigned)wid * 1024u;
    const int aoff = lds_byte(wr * 64 + fr, fq * 8), boff = lds_byte(wc * 32 + fr, fq * 8);
#define PG8_SA(b, h) (((b) * 2 + (h)) * HTB)
#define PG8_SB(b, h) ((4 + (b) * 2 + (h)) * HTB)
#define PG8_STAGE(bufoff, gbase, voff) do { _Pragma("unroll") for (int _i = 0; _i < 2; ++_i) \
        __builtin_amdgcn_global_load_lds((const unsigned*)((const char*)(gbase) + _i * pstep + (voff)), (PG8_LAS unsigned*)(lds + (bufoff) + ldsw + _i * 8192), 16, 0, 0); } while (0)
#define PG8_LDA(dst, b, h) do { _Pragma("unroll") for (int m = 0; m < 4; ++m) _Pragma("unroll") for (int k = 0; k < 2; ++k) dst[m][k] = *(const PG8_LAS bf16x8*)(lds + PG8_SA(b, h) + aoff + m * 2048 + k * 1024); } while (0)
#define PG8_LDB(dst, b, h) do { _Pragma("unroll") for (int n = 0; n < 2; ++n) _Pragma("unroll") for (int k = 0; k < 2; ++k) dst[n][k] = *(const PG8_LAS bf16x8*)(lds + PG8_SB(b, h) + boff + n * 2048 + k * 1024); } while (0)
#define PG8_MMA(ai, bj, At, Bt) do { __builtin_amdgcn_s_setprio(1); _Pragma("unroll") for (int m = 0; m < 4; ++m) _Pragma("unroll") for (int n = 0; n < 2; ++n) { \
        if constexpr (FP8) {   \
            const i32x8 fa_ = __builtin_bit_cast(i32x8, __builtin_shufflevector(At[m][0], At[m][1], 0, 1, 2, 3, 4, 5, 6, 7, 8, 9, 10, 11, 12, 13, 14, 15)); \
            const i32x8 fb_ = __builtin_bit_cast(i32x8, __builtin_shufflevector(Bt[n][0], Bt[n][1], 0, 1, 2, 3, 4, 5, 6, 7, 8, 9, 10, 11, 12, 13, 14, 15)); \
            acc[ai][bj][m][n] = __builtin_amdgcn_mfma_scale_f32_16x16x128_f8f6f4(fb_, fa_, acc[ai][bj][m][n], 0, 0, 0, 0x7f7f7f7f, 0, 0x7f7f7f7f); \
        } else { _Pragma("unroll") for (int k = 0; k < 2; ++k) acc[ai][bj][m][n] = __builtin_amdgcn_mfma_f32_16x16x32_bf16(Bt[n][k], At[m][k], acc[ai][bj][m][n], 0, 0, 0); } } \
        __builtin_amdgcn_s_setprio(0); } while (0)
#define PG8_WAIT_V(n) asm volatile("s_waitcnt vmcnt(" #n ")" ::: "memory")
#define PG8_WAIT_L(n) asm volatile("s_waitcnt lgkmcnt(" #n ")" ::: "memory")
#define PG8_BAR __builtin_amdgcn_s_barrier()
#define PG8_SCHED __builtin_amdgcn_sched_barrier(0)
    Unit cur, nxt; int ui = 0;
    if (!S.next(0, cur)) return;
    f32x4 acc[2][2][4][2];
#pragma unroll
    for (int a = 0; a < 2; ++a)
#pragma unroll
        for (int b = 0; b < 2; ++b)
#pragma unroll
            for (int m = 0; m < 4; ++m)
#pragma unroll
                for (int n = 0; n < 2; ++n) acc[a][b][m][n] = (f32x4){0.f, 0.f, 0.f, 0.f};
    bf16x8 At[4][2], B0[2][2], B1[2][2];
    const char* cA = (const char*)S.pa(cur) + (size_t)cur.pm * tstep; const char* cB = (const char*)S.pb(cur) + (size_t)cur.pn * tstep;
    if constexpr (SP2) {
        PG8_STAGE(PG8_SB(0, 0), cB, voffB); PG8_STAGE(PG8_SB(0, 1), cB + hstep, voffB); PG8_STAGE(PG8_SA(0, 0), cA, voffA); PG8_STAGE(PG8_SA(0, 1), cA + hstep, voffA);
        if (wr == 1) PG8_BAR;
        PG8_WAIT_V(2); PG8_BAR;
        PG8_STAGE(PG8_SB(1, 0), cB + kstep, voffB); PG8_STAGE(PG8_SA(1, 0), cA + kstep, voffA); PG8_STAGE(PG8_SB(1, 1), cB + hstep + kstep, voffB);
        PG8_WAIT_V(6); PG8_BAR;
    } else {
        PG8_STAGE(PG8_SB(0, 0), cB, voffB); PG8_STAGE(PG8_SA(0, 0), cA, voffA); PG8_STAGE(PG8_SB(0, 1), cB + hstep, voffB); PG8_STAGE(PG8_SA(0, 1), cA + hstep, voffA);
        if (wr == 1) PG8_BAR;
        PG8_WAIT_V(4); PG8_BAR;
        PG8_STAGE(PG8_SB(1, 0), cB + kstep, voffB); PG8_STAGE(PG8_SA(1, 0), cA + kstep, voffA); PG8_STAGE(PG8_SB(1, 1), cB + hstep + kstep, voffB);
        PG8_WAIT_V(6); PG8_BAR;
    }
    for (;;) {
        const bool has_next = S.next(ui + 1, nxt);
        if (!has_next) S.last_unit(wid, lane);
        const char* nA = has_next ? (const char*)S.pa(nxt) + (size_t)nxt.pm * tstep : cA; const char* nB = has_next ? (const char*)S.pb(nxt) + (size_t)nxt.pn * tstep : cB;
#pragma unroll 1
        for (int t = 0; t < nt; t += 2) {
            const bool last = (t == nt - 2);
            const char* a1 = uni(cA + (size_t)(t + 1) * kstep);
            const char* a2 = uni(last ? nA : cA + (size_t)(t + 2) * kstep); const char* b2 = uni(last ? nB : cB + (size_t)(t + 2) * kstep);
            const char* a3 = a2 + kstep; const char* b3 = b2 + kstep;
            if constexpr (SP2) {
            PG8_LDB(B0, 0, 0); PG8_LDB(B1, 0, 1); PG8_SCHED; PG8_LDA(At, 0, 0); PG8_STAGE(PG8_SA(1, 1), a1 + hstep, voffA);
            PG8_WAIT_V(8); PG8_WAIT_L(0); PG8_BAR; PG8_MMA(0, 0, At, B0); PG8_MMA(0, 1, At, B1); PG8_BAR; PG8_SCHED;
            PG8_LDA(At, 0, 1); PG8_STAGE(PG8_SB(0, 0), b2, voffB); PG8_STAGE(PG8_SB(0, 1), b2 + hstep, voffB); PG8_STAGE(PG8_SA(0, 0), a2, voffA);
            PG8_WAIT_V(8); PG8_WAIT_L(0); PG8_BAR; PG8_MMA(1, 0, At, B0); PG8_MMA(1, 1, At, B1); PG8_BAR; PG8_SCHED;
            PG8_LDB(B0, 1, 0); PG8_LDB(B1, 1, 1); PG8_SCHED; PG8_LDA(At, 1, 0); PG8_STAGE(PG8_SA(0, 1), a2 + hstep, voffA);
            PG8_WAIT_V(8); PG8_WAIT_L(0); PG8_BAR; PG8_MMA(0, 0, At, B0); PG8_MMA(0, 1, At, B1); PG8_BAR; PG8_SCHED;
            PG8_LDA(At, 1, 1); PG8_STAGE(PG8_SB(1, 0), b3, voffB); PG8_STAGE(PG8_SB(1, 1), b3 + hstep, voffB); PG8_STAGE(PG8_SA(1, 0), a3, voffA);
            PG8_WAIT_V(8); PG8_WAIT_L(0); PG8_BAR; PG8_MMA(1, 0, At, B0); PG8_MMA(1, 1, At, B1); PG8_BAR; PG8_SCHED;
            } else {
            PG8_LDB(B0, 0, 0); PG8_SCHED; PG8_LDA(At, 0, 0); PG8_STAGE(PG8_SA(1, 1), a1 + hstep, voffA);
            PG8_WAIT_L(8); PG8_BAR; PG8_WAIT_L(0); PG8_MMA(0, 0, At, B0); PG8_BAR; PG8_SCHED;
            PG8_LDB(B1, 0, 1); PG8_STAGE(PG8_SB(0, 0), b2, voffB);
            PG8_BAR; PG8_WAIT_L(0); PG8_MMA(0, 1, At, B1); PG8_BAR;
            PG8_LDA(At, 0, 1); PG8_STAGE(PG8_SA(0, 0), a2, voffA);
            PG8_BAR; PG8_WAIT_L(0); PG8_MMA(1, 0, At, B0); PG8_BAR; PG8_SCHED;
            PG8_STAGE(PG8_SB(0, 1), b2 + hstep, voffB);
            PG8_WAIT_V(6); PG8_BAR; PG8_MMA(1, 1, At, B1); PG8_BAR;
            PG8_LDB(B0, 1, 0); PG8_SCHED; PG8_LDA(At, 1, 0); PG8_STAGE(PG8_SA(0, 1), a2 + hstep, voffA);
            PG8_WAIT_L(8); PG8_BAR; PG8_WAIT_L(0); PG8_MMA(0, 0, At, B0); PG8_BAR; PG8_SCHED;
            PG8_LDB(B1, 1, 1); PG8_STAGE(PG8_SB(1, 0), b3, voffB);
            PG8_BAR; PG8_WAIT_L(0); PG8_MMA(0, 1, At, B1); PG8_BAR;
            PG8_LDA(At, 1, 1); PG8_STAGE(PG8_SA(1, 0), a3, voffA);
            PG8_BAR; PG8_WAIT_L(0); PG8_MMA(1, 0, At, B0); PG8_BAR; PG8_SCHED;
            PG8_STAGE(PG8_SB(1, 1), b3 + hstep, voffB);
            PG8_WAIT_V(6); PG8_BAR; PG8_MMA(1, 1, At, B1); PG8_BAR;
            }
        }
        if constexpr (ALIGN_EPI) { if (wr == 0) PG8_BAR; }
        const bool keep = E(acc, cur, wr, wc, fr, fq);
        if (!has_next) break;
        if (!keep) {
#pragma unroll
            for (int a = 0; a < 2; ++a)
#pragma unroll
                for (int b = 0; b < 2; ++b)
#pragma unroll
                    for (int m = 0; m < 4; ++m)
#pragma unroll
                        for (int n = 0; n < 2; ++n) acc[a][b][m][n] = (f32x4){0.f, 0.f, 0.f, 0.f};
        }
        cur = nxt; cA = nA; cB = nB; ++ui;
        if constexpr (ALIGN_EPI) { if (wr == 1) PG8_BAR; }
    }
    PG8_WAIT_V(0);
    if constexpr (!ALIGN_EPI) { if (wr == 0) PG8_BAR; }
    PG8_BAR;
#undef PG8_SA
#undef PG8_SB
#undef PG8_STAGE
#undef PG8_LDA
#undef PG8_LDB
#undef PG8_MMA
#undef PG8_WAIT_V
#undef PG8_WAIT_L
#undef PG8_BAR
#undef PG8_SCHED
}
}

typedef unsigned short bf16;
typedef unsigned v4u __attribute__((ext_vector_type(4)));
typedef unsigned v2u __attribute__((ext_vector_type(2)));
typedef float f32x4 __attribute__((ext_vector_type(4)));
typedef float f32x16 __attribute__((ext_vector_type(16)));
typedef short bf16x8 __attribute__((ext_vector_type(8)));
typedef GAS unsigned gu32;

constexpr int NWAVES = 8, NTHR = 512;
constexpr int BATCH = 8, SEQ = 2048, T = BATCH * SEQ, D = 1024;
constexpr int NH = 4, DK = 128, DV = 256, CH = 128, NCH = SEQ / CH;
constexpr int QK = NH * DK, VD = NH * DV;
constexpr int RANK = 16;
constexpr int NE = 16, CAP = 256, DFF = 2816, EROWS = BATCH * CAP;
constexpr int DIN = 8224, DINP = 8448;
constexpr float EPS = 1e-6f;
constexpr int NPHASE = 12;

constexpr size_t MiB = 1u << 20;
constexpr size_t WS_CTL = 0, CTL_ZERO_BYTES = 1 * MiB;
constexpr size_t WS_WBR = 1 * MiB, WS_WBG = 3 * MiB, WS_WOUT = 5 * MiB;
constexpr size_t WS_AL = 7 * MiB, WS_BE = 8 * MiB;
constexpr size_t WS_AFF = 9 * MiB;
constexpr size_t WS_RK = 10 * MiB;
constexpr size_t WS_GATEV = 11 * MiB;
constexpr size_t WS_GA = 12 * MiB;
constexpr size_t WS_WGU = 16 * MiB;
constexpr size_t WS_R0 = 192 * MiB;
constexpr size_t WS_R1 = 256 * MiB;
constexpr size_t WS_R2 = 320 * MiB;
constexpr size_t WS_R3 = 384 * MiB;
constexpr size_t WS_R4 = 512 * MiB;
constexpr size_t WS_QKR = WS_R0, WS_RO = WS_R0, WS_Y = WS_R0;
constexpr size_t WS_V = WS_R1, WS_MERGED = WS_R1, WS_H2 = WS_R1 + 32 * MiB;
constexpr size_t WS_G = WS_R2, WS_XG = WS_R2;
constexpr size_t WS_QT = WS_R3, WS_KT = WS_R3 + 64 * MiB, WS_ACT = WS_R3;
constexpr size_t WS_XN = WS_R4, WS_WIN = WS_R4 + 32 * MiB, WS_RT = WS_R4;
constexpr size_t WS_WDN = MOE_FP8 ? 104 * MiB : 560 * MiB;
constexpr size_t WS_END = 648 * MiB;
static_assert(MOE_FP8 ? (WS_WGU + (size_t)NE * 2 * DFF * D <= WS_WDN && WS_WDN + (size_t)NE * D * DFF <= WS_R0) : (WS_ACT + (size_t)NE * EROWS * DFF * 2 <= WS_WDN && WS_WDN + (size_t)NE * D * DFF * 2 <= WS_END), "WDN placement");
static_assert(WS_WIN + (size_t)DINP * D * 2 <= WS_R4 + 128 * MiB, "WIN fits");
constexpr int CW_CONVQ = 64;
constexpr int CW_DONE = 128;
constexpr int CW_BAR = 4096;

constexpr int RING_BYTES = 131072;
constexpr int LDSCTL_OFF = RING_BYTES, MISC_OFF = LDSCTL_OFF + 320;
constexpr int LDS_BYTES = 147456;

#define RLX_AGENT __ATOMIC_RELAXED, __HIP_MEMORY_SCOPE_AGENT
#define LDS_WAIT() asm volatile("s_waitcnt lgkmcnt(0)" ::: "memory")
#define VM_WAIT() asm volatile("s_waitcnt vmcnt(0)" ::: "memory")
__device__ __forceinline__ unsigned f2bf(float f) { unsigned u = __builtin_bit_cast(unsigned, f); return (u + 0x7fffu + ((u >> 16) & 1u)) >> 16; }
__device__ __forceinline__ unsigned pk2(float lo, float hi) { unsigned r; asm("v_cvt_pk_bf16_f32 %0, %1, %2" : "=v"(r) : "v"(lo), "v"(hi)); return r; }
__device__ __forceinline__ float bf2f(unsigned u16) { return __builtin_bit_cast(float, u16 << 16); }
__device__ __forceinline__ float bflo(unsigned w) { return __builtin_bit_cast(float, w << 16); }
__device__ __forceinline__ float bfhi(unsigned w) { return __builtin_bit_cast(float, w & 0xffff0000u); }
__device__ __forceinline__ unsigned pk4_fp8(float a, float b, float c, float d) {
    a = __builtin_amdgcn_fmed3f(a, -448.f, 448.f); b = __builtin_amdgcn_fmed3f(b, -448.f, 448.f); c = __builtin_amdgcn_fmed3f(c, -448.f, 448.f); d = __builtin_amdgcn_fmed3f(d, -448.f, 448.f);
    int w = 0; w = __builtin_amdgcn_cvt_pk_fp8_f32(a, b, w, false); w = __builtin_amdgcn_cvt_pk_fp8_f32(c, d, w, true); return (unsigned)w; }
constexpr float SC_W = 256.f, SC_H = 8.f, SC_A = 4.f;
__device__ __forceinline__ float fast_sigmoid(float x) { return __builtin_amdgcn_rcpf(1.0f + __builtin_amdgcn_exp2f(-1.4426950408889634f * x)); }
__device__ __forceinline__ float fast_silu(float x) { return x * fast_sigmoid(x); }
__device__ __forceinline__ float log_sigmoid(float z) { return fminf(z, 0.f) - log1pf(expf(-fabsf(z))); }
__device__ __forceinline__ float fexp(float x) { return __builtin_amdgcn_exp2f(1.4426950408889634f * x); }
__device__ __forceinline__ float fast_log_sigmoid(float z) { return fminf(z, 0.f) - 0.6931471805599453f * __builtin_amdgcn_logf(1.0f + fexp(-fabsf(z))); }

#define XB_TMO      128
#define XB_XCNT(j)  (256  + 64 * (j))
#define XB_XSUB(j)  (1280 + 64 * (j))
#define XB_XGEN(j)  (2304 + 64 * (j))
#define XB_TOP      3328
#define XB_TOPGEN   3392
#define XCD_BAR_WORDS 3456
#define XB_SPIN_CAP (1u << 20)
__device__ __forceinline__ unsigned xb_ld(unsigned* p)              { return __hip_atomic_load(p, __ATOMIC_RELAXED, __HIP_MEMORY_SCOPE_AGENT); }
__device__ __forceinline__ unsigned xb_add(unsigned* p, unsigned v) { return __hip_atomic_fetch_add(p, v, __ATOMIC_RELAXED, __HIP_MEMORY_SCOPE_AGENT); }
__device__ __forceinline__ unsigned xb_xcc_id() { return (unsigned)__builtin_amdgcn_s_getreg((3 << 11) | 20) & 0xFu; }
#define XB_SPIN(cond, bar) do { unsigned _sp = 0; while (cond) { __builtin_amdgcn_s_sleep(1); \
    if ((++_sp & 255u) == 0u) { if (xb_ld(&(bar)[XB_TMO])) break; if (_sp > XB_SPIN_CAP) { atomicAdd(&(bar)[XB_TMO], 1u); break; } } } } while (0)
struct XcdBarrier { unsigned* bar; unsigned x; volatile LAS unsigned* st; unsigned G; int wave; };
__device__ __forceinline__ XcdBarrier xcd_barrier_post(unsigned* bar, volatile LAS unsigned* st, int wave) {
    XcdBarrier b; b.bar = bar; b.x = xb_xcc_id(); b.st = st; b.G = 0; b.wave = wave;
    if (wave == 0 && lane_id_now() == 0) (void)xb_add(&bar[XB_XCNT(b.x)], 1u);
    return b;
}
__device__ __forceinline__ void xcd_barrier_complete(unsigned* bar, unsigned x, unsigned G_, unsigned& nloc, unsigned& nx) {
    const unsigned G = (unsigned)__builtin_amdgcn_readfirstlane(G_);
    unsigned sum, cnt, mine, sp = 0u;
    for (;;) {
        sum = 0u; cnt = 0u; mine = 0u;
#pragma unroll
        for (unsigned j = 0; j < 16; ++j) { const unsigned c = xb_ld(&bar[XB_XCNT(j)]); sum += c; cnt += (c > 0u) ? 1u : 0u; mine = (j == x) ? c : mine; }
        if ((unsigned)__builtin_amdgcn_readfirstlane(sum) == G) break;
        __builtin_amdgcn_s_sleep(1);
        if ((++sp & 255u) == 0u) { if (xb_ld(&bar[XB_TMO])) break; if (sp > XB_SPIN_CAP) { atomicAdd(&bar[XB_TMO], 1u); break; } }
    }
    nloc = mine > 0u ? mine : 1u; nx = cnt > 0u ? cnt : 1u;
}
__device__ __forceinline__ void xcd_barrier(const XcdBarrier& b, const unsigned G) {
    asm volatile("s_waitcnt vmcnt(0)" ::: "memory");
    __syncthreads();
    if (b.wave == 0 && lane_id_now() == 0) {
        unsigned* bar = b.bar;
        __builtin_amdgcn_s_waitcnt(0);
        unsigned nloc = b.st[0], nx = b.st[1];
        if (nloc == 0u) { xcd_barrier_complete(bar, b.x, G, nloc, nx); b.st[0] = nloc; b.st[1] = nx; }
        const unsigned old = xb_add(&bar[XB_XSUB(b.x)], 1u);
        const unsigned gen = old / nloc;
        if (old + 1u == (gen + 1u) * nloc) {
            __builtin_amdgcn_fence(__ATOMIC_RELEASE, "agent");
            asm volatile("s_waitcnt vmcnt(0)" ::: "memory");
            const unsigned og = xb_add(&bar[XB_TOP], 1u);
            const unsigned tg = og / nx;
            if (og + 1u == (tg + 1u) * nx) xb_add(&bar[XB_TOPGEN], 1u);
            else XB_SPIN(xb_ld(&bar[XB_TOPGEN]) == tg, bar);
            __builtin_amdgcn_fence(__ATOMIC_ACQUIRE, "agent");
            xb_add(&bar[XB_XGEN(b.x)], 1u);
            asm volatile("s_waitcnt vmcnt(0)" ::: "memory");
        } else {
            XB_SPIN(xb_ld(&bar[XB_XGEN(b.x)]) == gen, bar);
            __builtin_amdgcn_fence(__ATOMIC_ACQUIRE, "agent");
            asm volatile("s_waitcnt vmcnt(0)" ::: "memory");
        }
    }
    __syncthreads();
}

struct Args { const float* in[21]; float* out; unsigned char* ws; int ph_lo, ph_hi, dup, grid; };
struct Frame {
    LAS unsigned char* lds;
    int tid, lane, wave, vcu, G;
    float* out; unsigned char* ws;
};
#define IN_X 0
#define IN_POS 1
#define IN_NORM_MIX 2
#define IN_W_IN 3
#define IN_RDF 4
#define IN_RDB 5
#define IN_RET_NORM 6
#define IN_GWF 7
#define IN_GBF 8
#define IN_GWB 9
#define IN_GBB 10
#define IN_GLA_NORM 11
#define IN_WBR 12
#define IN_WBG 13
#define IN_WOUT 14
#define IN_NORM_FFN 15
#define IN_W_ROUTER 16
#define IN_W_GATE 17
#define IN_W_UP 18
#define IN_W_DOWN 19
#define IN_NORM_FINAL 20

__device__ __forceinline__ float wave_sum(float v) {
#pragma unroll
    for (int o = 1; o < 64; o <<= 1) v += __shfl_xor(v, o);
    return v;
}

struct TrItem { const float* W; bf16* WT; int N, K, kb, n0, drow0, f8; };
__device__ __forceinline__ void tr_load(const TrItem& t, int lane, f32x4 (&v)[8]) {
    const int k0 = 64 * t.kb, c4 = lane & 7, r8 = lane >> 3;
#pragma unroll
    for (int i = 0; i < 8; ++i) v[i] = __builtin_nontemporal_load((const f32x4*)(t.W + (size_t)(k0 + 8 * i + r8) * t.N + t.n0 + 4 * c4));
}
__device__ __forceinline__ void tr_finish(const TrItem& t, int lane, const f32x4 (&v)[8], LAS float* scr) {
    const int k0 = 64 * t.kb, c4 = lane & 7, r8 = lane >> 3;
#pragma unroll
    for (int i = 0; i < 8; ++i) { LAS float* d = scr + (8 * i + r8) * 33 + 4 * c4; d[0] = v[i].x; d[1] = v[i].y; d[2] = v[i].z; d[3] = v[i].w; }
    LDS_WAIT(); asm volatile("" ::: "memory");
    const int c = lane & 7;
    if (t.f8) {
#pragma unroll
        for (int j = 0; j < 4; ++j) { const int n = (lane >> 3) + 8 * j; const LAS float* s = scr + (8 * c) * 33 + n;
            v2u o; o.x = pk4_fp8(s[0 * 33] * SC_W, s[1 * 33] * SC_W, s[2 * 33] * SC_W, s[3 * 33] * SC_W); o.y = pk4_fp8(s[4 * 33] * SC_W, s[5 * 33] * SC_W, s[6 * 33] * SC_W, s[7 * 33] * SC_W);
            *(GAS v2u*)((unsigned char*)t.WT + (size_t)(t.drow0 + n) * t.K + k0 + 8 * c) = o; }
    } else {
#pragma unroll
        for (int j = 0; j < 4; ++j) { const int n = (lane >> 3) + 8 * j; const LAS float* s = scr + (8 * c) * 33 + n;
            v4u o; o.x = pk2(s[0 * 33], s[1 * 33]); o.y = pk2(s[2 * 33], s[3 * 33]); o.z = pk2(s[4 * 33], s[5 * 33]); o.w = pk2(s[6 * 33], s[7 * 33]);
            *(GAS v4u*)(t.WT + (size_t)(t.drow0 + n) * t.K + k0 + 8 * c) = o; }
    }
    LDS_WAIT(); asm volatile("" ::: "memory");
}
__device__ __forceinline__ void rms_row_store(int lane, const f32x4 (&v)[4], const f32x4 (&g)[4], bf16* orow) {
    float s = 0.f;
#pragma unroll
    for (int j = 0; j < 4; ++j) s += (v[j].x * v[j].x + v[j].y * v[j].y) + (v[j].z * v[j].z + v[j].w * v[j].w);
    const float rstd = 1.f / sqrtf(wave_sum(s) * (1.f / D) + EPS);
    GAS v2u* o8 = (GAS v2u*)orow + lane;
#pragma unroll
    for (int j = 0; j < 4; ++j) { v2u o; o.x = pk2(v[j].x * rstd * g[j].x, v[j].y * rstd * g[j].y); o.y = pk2(v[j].z * rstd * g[j].z, v[j].w * rstd * g[j].w); o8[64 * j] = o; }
}

constexpr int P0_I_IN = (D / 64) * (DIN / 32);
constexpr int P0_I_SQ = (D / 64) * (D / 32);
constexpr int P0_NSTATIC = P0_I_IN + 3 * P0_I_SQ;
constexpr int QY_PER = (D / 128) * (DFF / 32);
constexpr int Q_GU1 = NE * QY_PER;
constexpr int Q_GU = 2 * Q_GU1, Q_DN = NE * QY_PER, Q_N = Q_GU + Q_DN;
constexpr int NG1 = 176;
constexpr int P1_ROUNDS = (64 * 33 + NG1 - 1) / NG1, P1_LATE = 64 * 33 - NG1 * (P1_ROUNDS - 1), P1_EARLY = NG1 - P1_LATE;
constexpr int Q_P1 = MOE_FP8 ? Q_N : Q_GU;
constexpr int QCH = 6;
template <int LIST> __device__ __forceinline__ void cv_decode(const Frame& F, const Args& A, int it, TrItem& t) {
    if (LIST == 0) {
        int r = it;
        if (r < P0_I_IN) { const int nblk = DIN / 32, kb = r / nblk, nb = r % nblk, n0 = 32 * nb;
            t.f8 = 0; t.W = A.in[IN_W_IN]; t.WT = (bf16*)(F.ws + WS_WIN); t.N = DIN; t.K = D; t.kb = kb; t.n0 = n0; t.drow0 = n0 < 6144 ? n0 : (n0 < 6176 ? 8192 + (n0 - 6144) : n0 - 32); return; }
        r -= P0_I_IN;
        { const int w = r / P0_I_SQ, q = r % P0_I_SQ;
          t.W = w == 0 ? A.in[IN_WBR] : (w == 1 ? A.in[IN_WBG] : A.in[IN_WOUT]); t.WT = (bf16*)(F.ws + (w == 0 ? WS_WBR : (w == 1 ? WS_WBG : WS_WOUT)));
          t.f8 = 0; t.N = D; t.K = D; t.kb = q / 32; t.n0 = 32 * (q % 32); t.drow0 = t.n0; }
    }
}
static_assert(MOE_FP8 == 1, "the expert-weight stream writes fp8 rows");
struct YItem { const float* src; unsigned char* dst; int N, K; };
__device__ __forceinline__ void y_decode(const Frame& F, const Args& A, int it, YItem& t) {
    if (it < Q_GU) { const int up = it / Q_GU1, q = it % Q_GU1, e = q / QY_PER, q2 = q % QY_PER, k0 = 128 * (q2 / (DFF / 32)), n0 = 32 * (q2 % (DFF / 32));
        const int drow0 = 256 * (n0 >> 7) + (n0 & 127) + (up ? 128 : 0);
        t.src = (up ? A.in[IN_W_UP] : A.in[IN_W_GATE]) + (size_t)e * D * DFF + (size_t)k0 * DFF + n0; t.N = DFF;
        t.dst = F.ws + WS_WGU + (size_t)e * (2 * DFF) * D + (size_t)drow0 * D + k0; t.K = D; return; }
    { const int r = it - Q_GU, e = r / QY_PER, q = r % QY_PER, k0 = 128 * (q / (D / 32)), n0 = 32 * (q % (D / 32));
      t.src = A.in[IN_W_DOWN] + (size_t)e * DFF * D + (size_t)k0 * D + n0; t.N = D;
      t.dst = F.ws + WS_WDN + (size_t)e * D * DFF + (size_t)n0 * DFF + k0; t.K = DFF; }
}
__device__ __forceinline__ void y_ld(const Frame& F, const Args& A, int it, f32x4 (&v)[16]) {
    YItem t; y_decode(F, A, it, t); const int r8 = F.lane >> 3, c4 = F.lane & 7;
    const float* p = t.src + (size_t)(16 * r8) * t.N + 4 * c4;
#pragma unroll
    for (int i = 0; i < 16; ++i) v[i] = __builtin_nontemporal_load((const f32x4*)(p + (size_t)i * t.N));
}
__device__ __forceinline__ void y_fin(const Frame& F, const Args& A, int it, const f32x4 (&v)[16]) {
    YItem t; y_decode(F, A, it, t); const int r8 = F.lane >> 3, c4 = F.lane & 7;
    unsigned char* d = t.dst + (size_t)(4 * c4) * t.K + 16 * r8;
#pragma unroll
    for (int x = 0; x < 4; ++x) { v4u o;
        o.x = pk4_fp8(v[0][x] * SC_W, v[1][x] * SC_W, v[2][x] * SC_W, v[3][x] * SC_W);     o.y = pk4_fp8(v[4][x] * SC_W, v[5][x] * SC_W, v[6][x] * SC_W, v[7][x] * SC_W);
        o.z = pk4_fp8(v[8][x] * SC_W, v[9][x] * SC_W, v[10][x] * SC_W, v[11][x] * SC_W);   o.w = pk4_fp8(v[12][x] * SC_W, v[13][x] * SC_W, v[14][x] * SC_W, v[15][x] * SC_W);
        *(GAS v4u*)(d + (size_t)x * t.K) = o; }
}
__device__ __forceinline__ void y_range(Frame& F, const Args& A, int first, int last, int stride) {
    if (first >= last) return;
    const int n = (last - first + stride - 1) / stride;
#define Y_IDX(k) (first + ((k) < n ? (k) : n - 1) * stride)
    f32x4 va[16], vb[16], vc[16];
    y_ld(F, A, Y_IDX(0), va); y_ld(F, A, Y_IDX(1), vb);
    for (int i = 0; i < n; i += 3) {
        y_ld(F, A, Y_IDX(i + 2), vc); y_fin(F, A, Y_IDX(i), va);
        y_ld(F, A, Y_IDX(i + 3), va); y_fin(F, A, Y_IDX(i + 1), vb);
        y_ld(F, A, Y_IDX(i + 4), vb); y_fin(F, A, Y_IDX(i + 2), vc);
    }
#undef Y_IDX
}
template <int LIST> __device__ __forceinline__ void cv_ld(const Frame& F, const Args& A, int it, f32x4 (&v)[8]) { TrItem t; cv_decode<LIST>(F, A, it, t); tr_load(t, F.lane, v); }
template <int LIST> __device__ __forceinline__ void cv_fin(const Frame& F, const Args& A, int it, const f32x4 (&v)[8], LAS float* scr) { TrItem t; cv_decode<LIST>(F, A, it, t); tr_finish(t, F.lane, v, scr); }
template <int LIST> __device__ __forceinline__ void cv_range(Frame& F, const Args& A, int first, int last, int stride, LAS float* scr) {
    if (first >= last) return;
    const int n = (last - first + stride - 1) / stride;
#define CV_IDX(k) (first + ((k) < n ? (k) : n - 1) * stride)
    f32x4 va[8], vb[8], vc[8];
    cv_ld<LIST>(F, A, CV_IDX(0), va); cv_ld<LIST>(F, A, CV_IDX(1), vb);
    for (int i = 0; i < n; i += 3) {
        cv_ld<LIST>(F, A, CV_IDX(i + 2), vc); cv_fin<LIST>(F, A, CV_IDX(i), va, scr);
        cv_ld<LIST>(F, A, CV_IDX(i + 3), va); cv_fin<LIST>(F, A, CV_IDX(i + 1), vb, scr);
        cv_ld<LIST>(F, A, CV_IDX(i + 4), vb); cv_fin<LIST>(F, A, CV_IDX(i + 2), vc, scr);
    }
#undef CV_IDX
}
__device__ __forceinline__ void p0_prologue(Frame& F, const Args& A) {
    LAS float* scr = (LAS float*)(F.lds + F.wave * 16384);
    const int gw = F.vcu * NWAVES + F.wave, NGW = F.G * NWAVES;
    bf16* WIN = (bf16*)(F.ws + WS_WIN);
    cv_range<0>(F, A, gw, P0_NSTATIC, NGW, scr);
    if (F.G != 256) y_range(F, A, gw, Q_N, NGW);
    for (int i = gw * 64 + F.lane; i < (DINP - DIN) * D / 8; i += NGW * 64) *(GAS v4u*)(WIN + (size_t)DIN * D + (size_t)i * 8) = (v4u){0u, 0u, 0u, 0u};
    bf16* XN = (bf16*)(F.ws + WS_XN);
    { f32x4 gm[4];
#pragma unroll
      for (int j = 0; j < 4; ++j) gm[j] = *((const GAS f32x4*)A.in[IN_NORM_MIX] + F.lane + 64 * j);
      for (int m0 = gw; m0 < T; m0 += 2 * NGW) {
          f32x4 va[4], vb[4]; const int m1 = m0 + NGW;
#pragma unroll
          for (int j = 0; j < 4; ++j) { va[j] = *((const GAS f32x4*)(A.in[IN_X] + (size_t)m0 * D) + F.lane + 64 * j); vb[j] = *((const GAS f32x4*)(A.in[IN_X] + (size_t)(m1 < T ? m1 : m0) * D) + F.lane + 64 * j); }
          rms_row_store(F.lane, va, gm, XN + (size_t)m0 * D);
          if (m1 < T) rms_row_store(F.lane, vb, gm, XN + (size_t)m1 * D);
      } }
}
struct P1Pull { unsigned d, it0; };
__device__ __forceinline__ P1Pull p1_pull_issue(gu32* ctr, gu32* done, int lane) {
    P1Pull r;
    if (lane == 0) { r.d = __hip_atomic_load(done, RLX_AGENT); const unsigned q_ = (unsigned)QCH; asm volatile("global_atomic_add %0, %1, %2, off sc0" : "=v"(r.it0) : "v"(ctr), "v"(q_) : "memory"); }
    return r;
}
__device__ __forceinline__ void p1_stream(Frame& F, const Args& A) {
    static_assert(QCH == 6, "the loop body below is written for chunks of six");
    gu32* ctr = (gu32*)(F.ws + WS_CTL) + CW_CONVQ; gu32* done = (gu32*)(F.ws + WS_CTL) + CW_DONE;
#define QI(base, k) ((base) + (k) < Q_P1 ? (base) + (k) : Q_P1 - 1)
    unsigned d0 = 0, t0 = 0;
    if (F.lane == 0) { d0 = __hip_atomic_load(done, RLX_AGENT); if (d0 <= (unsigned)P1_EARLY) t0 = __hip_atomic_fetch_add(ctr, (unsigned)QCH, RLX_AGENT); }
    d0 = __builtin_amdgcn_readfirstlane(d0); t0 = __builtin_amdgcn_readfirstlane(t0);
    if (d0 > (unsigned)P1_EARLY || t0 >= (unsigned)Q_P1) return;
    int i0 = (int)t0; bool stopping = false;
    f32x4 va[16], vb[16], vc[16];
    y_ld(F, A, QI(i0, 0), va); y_ld(F, A, QI(i0, 1), vb);
    for (;;) {
        P1Pull pr; if (!stopping) pr = p1_pull_issue(ctr, done, F.lane);
        y_ld(F, A, QI(i0, 2), vc); y_fin(F, A, QI(i0, 0), va);
        y_ld(F, A, QI(i0, 3), va); y_fin(F, A, QI(i0, 1), vb);
        y_ld(F, A, QI(i0, 4), vb); y_fin(F, A, QI(i0, 2), vc);
        y_ld(F, A, QI(i0, 5), vc); y_fin(F, A, QI(i0, 3), va);
        __builtin_amdgcn_sched_barrier(0);
        int it1 = -1; bool stop_next = true;
        if (!stopping) { const unsigned d = __builtin_amdgcn_readfirstlane(pr.d), t = __builtin_amdgcn_readfirstlane(pr.it0); it1 = t < (unsigned)Q_P1 ? (int)t : -1; stop_next = d > (unsigned)P1_EARLY; }
        const int i1 = it1 >= 0 ? it1 : i0;
        y_ld(F, A, QI(i1, 0), va); y_fin(F, A, QI(i0, 4), vb);
        y_ld(F, A, QI(i1, 1), vb); y_fin(F, A, QI(i0, 5), vc);
        if (it1 < 0) break;
        i0 = i1; stopping = stop_next;
    }
#undef QI
}

struct SchedPlain {
    int nM, nN, G, c; const bf16* A; const bf16* Bt; gu32* lastctr;
    __device__ __forceinline__ void last_unit(int wid, int lane) const { if (lastctr && wid == 0 && lane == 0) __hip_atomic_fetch_add(lastctr, 1u, RLX_AGENT); }
    __device__ __forceinline__ bool next(int i, pg8::Unit& u) const {
        const long L = (long)i * G + c; if (L >= (long)nM * nN) return false;
        pg8::tile_of((int)L, nM, nN, u.pm, u.pn); u.aux = 0; return true; }
    __device__ __forceinline__ const bf16* pa(const pg8::Unit&) const { return A; }
    __device__ __forceinline__ const bf16* pb(const pg8::Unit&) const { return Bt; }
};
struct SchedBranch {
    int G, c; const bf16* A0; const bf16* A1; const bf16* B0; const bf16* B1;
    __device__ __forceinline__ void last_unit(int, int) const {}
    __device__ __forceinline__ bool next(int i, pg8::Unit& u) const {
        const long L = (long)(i >> 1) * G + c; if (L >= 64 * 4) return false;
        pg8::tile_of((int)L, 64, 4, u.pm, u.pn); u.aux = i & 1; return true; }
    __device__ __forceinline__ const bf16* pa(const pg8::Unit& u) const { return u.aux ? A1 : A0; }
    __device__ __forceinline__ const bf16* pb(const pg8::Unit& u) const { return u.aux ? B1 : B0; }
};
struct SchedMoe {
    int NP, G, c; const bf16* A; const bf16* Bt;
    __device__ __forceinline__ void last_unit(int, int) const {}
    __device__ __forceinline__ bool next(int i, pg8::Unit& u) const {
        const int nwg = NE * 8 * NP; const long L = (long)i * G + c; if (L >= nwg) return false;
        int wgid = (int)L; { const int q = nwg / 8, xcd = wgid % 8, off = wgid / 8; wgid = xcd * q + off; }
        const int e = wgid / (8 * NP), rem = wgid % (8 * NP), pnl = rem / 8, pml = rem % 8;
        u.pm = e * 8 + pml; u.pn = e * NP + pnl; u.aux = pnl; return true; }
    __device__ __forceinline__ const bf16* pa(const pg8::Unit&) const { return A; }
    __device__ __forceinline__ const bf16* pb(const pg8::Unit&) const { return Bt; }
};

struct EpiInProj {
    static constexpr bool PERM = true;
    bf16* QKR; bf16* V; bf16* Gt; bf16* SG; float* GA;
    __device__ __forceinline__ bool operator()(pg8::f32x4 (&acc)[2][2][4][2], const pg8::Unit& u, int wr, int wc, int fr, int fq) const {
        const int pn = u.pn; const int row0 = u.pm * 256 + wr * 64 + fr;
        if (pn == 32) {
            if (wc == 0) {
#pragma unroll
                for (int ai = 0; ai < 2; ++ai)
#pragma unroll
                    for (int m = 0; m < 4; ++m) { float* rp = GA + (size_t)(row0 + ai * 128 + m * 16) * 32 + 8 * fq;
                        *(pg8::f32x4*)(rp) = acc[ai][0][m][0]; *(pg8::f32x4*)(rp + 4) = acc[ai][0][m][1]; }
            }
            return false;
        }
        bf16* base; int ldc, colt, act;
        if (pn < 2)       { base = QKR;                         ldc = QK; colt = pn * 256;        act = 0; }
        else if (pn < 4)  { base = QKR + (size_t)1 * T * QK;    ldc = QK; colt = (pn - 2) * 256;  act = 0; }
        else if (pn < 8)  { base = V;                           ldc = VD; colt = (pn - 4) * 256;  act = 0; }
        else if (pn < 12) { base = Gt;                          ldc = VD; colt = (pn - 8) * 256;  act = 1; }
        else if (pn < 14) { base = QKR + (size_t)2 * T * QK;    ldc = QK; colt = (pn - 12) * 256; act = 0; }
        else if (pn < 16) { base = QKR + (size_t)3 * T * QK;    ldc = QK; colt = (pn - 14) * 256; act = 0; }
        else if (pn < 20) { base = V + (size_t)T * VD;          ldc = VD; colt = (pn - 16) * 256; act = 0; }
        else if (pn < 24) { base = Gt + (size_t)T * VD;         ldc = VD; colt = (pn - 20) * 256; act = 1; }
        else if (pn < 28) { base = SG;                          ldc = VD; colt = (pn - 24) * 256; act = 2; }
        else              { base = SG + (size_t)T * VD;         ldc = VD; colt = (pn - 28) * 256; act = 2; }
        const int col0 = colt + wc * 32 + 8 * fq;
#pragma unroll
        for (int ai = 0; ai < 2; ++ai)
#pragma unroll
            for (int m = 0; m < 4; ++m) { bf16* rowp = base + (size_t)(row0 + ai * 128 + m * 16) * ldc + col0;
#pragma unroll
                for (int bj = 0; bj < 2; ++bj) { pg8::f32x4 v0 = acc[ai][bj][m][0], v1 = acc[ai][bj][m][1];
                    if (act == 1) {
#pragma unroll
                        for (int x = 0; x < 4; ++x) { v0[x] = fast_silu(v0[x]); v1[x] = fast_silu(v1[x]); } }
                    else if (act == 2) {
#pragma unroll
                        for (int x = 0; x < 4; ++x) { v0[x] = fast_sigmoid(v0[x]); v1[x] = fast_sigmoid(v1[x]); } }
                    pg8::u32x4 w; w.x = pg8::cvt_pk_bf16(v0[0], v0[1]); w.y = pg8::cvt_pk_bf16(v0[2], v0[3]); w.z = pg8::cvt_pk_bf16(v1[0], v1[1]); w.w = pg8::cvt_pk_bf16(v1[2], v1[3]);
                    *(pg8::u32x4*)(rowp + bj * 128) = w; } }
        return false;
    }
};
struct EpiBranch {
    static constexpr bool PERM = true;
    const bf16* SG; bf16* O;
    __device__ __forceinline__ bool operator()(pg8::f32x4 (&acc)[2][2][4][2], const pg8::Unit& u, int wr, int wc, int fr, int fq) const {
        const int row0 = u.pm * 256 + wr * 64 + fr, col0 = u.pn * 256 + wc * 32 + 8 * fq;
        if (u.aux == 0) {
#pragma unroll
            for (int ai = 0; ai < 2; ++ai) {
                pg8::u32x4 g1[4][2], g0[4][2];
#pragma unroll
                for (int m = 0; m < 4; ++m)
#pragma unroll
                    for (int bj = 0; bj < 2; ++bj) { const size_t off = (size_t)(row0 + ai * 128 + m * 16) * VD + col0 + bj * 128;
                        g1[m][bj] = *(const pg8::u32x4*)(SG + (size_t)T * VD + off); g0[m][bj] = *(const pg8::u32x4*)(SG + off); }
#pragma unroll
                for (int m = 0; m < 4; ++m)
#pragma unroll
                    for (int bj = 0; bj < 2; ++bj) { const pg8::u32x4 a1 = g1[m][bj], a0 = g0[m][bj];
                        pg8::f32x4 s1a = {bflo(a1.x), bfhi(a1.x), bflo(a1.y), bfhi(a1.y)}, s1b = {bflo(a1.z), bfhi(a1.z), bflo(a1.w), bfhi(a1.w)};
                        pg8::f32x4 s0a = {bflo(a0.x), bfhi(a0.x), bflo(a0.y), bfhi(a0.y)}, s0b = {bflo(a0.z), bfhi(a0.z), bflo(a0.w), bfhi(a0.w)};
#pragma unroll
                        for (int x = 0; x < 4; ++x) { acc[ai][bj][m][0][x] *= s0a[x] * __builtin_amdgcn_rcpf(s1a[x]); acc[ai][bj][m][1][x] *= s0b[x] * __builtin_amdgcn_rcpf(s1b[x]); } }
            }
            return true;
        }
#pragma unroll
        for (int ai = 0; ai < 2; ++ai) {
            pg8::u32x4 g1[4][2];
#pragma unroll
            for (int m = 0; m < 4; ++m)
#pragma unroll
                for (int bj = 0; bj < 2; ++bj) g1[m][bj] = *(const pg8::u32x4*)(SG + (size_t)T * VD + (size_t)(row0 + ai * 128 + m * 16) * VD + col0 + bj * 128);
#pragma unroll
            for (int m = 0; m < 4; ++m)
#pragma unroll
                for (int bj = 0; bj < 2; ++bj) { const pg8::u32x4 a1 = g1[m][bj];
                    pg8::f32x4 s1a = {bflo(a1.x), bfhi(a1.x), bflo(a1.y), bfhi(a1.y)}, s1b = {bflo(a1.z), bfhi(a1.z), bflo(a1.w), bfhi(a1.w)};
                    const pg8::f32x4 v0 = acc[ai][bj][m][0] * s1a, v1 = acc[ai][bj][m][1] * s1b;
                    pg8::u32x4 w; w.x = pg8::cvt_pk_bf16(v0[0], v0[1]); w.y = pg8::cvt_pk_bf16(v0[2], v0[3]); w.z = pg8::cvt_pk_bf16(v1[0], v1[1]); w.w = pg8::cvt_pk_bf16(v1[2], v1[3]);
                    *(pg8::u32x4*)(O + (size_t)(row0 + ai * 128 + m * 16) * VD + col0 + bj * 128) = w; }
        }
        return false;
    }
};
struct EpiOut {
    static constexpr bool PERM = false;
    const float* X; float* O;
    __device__ __forceinline__ bool operator()(pg8::f32x4 (&acc)[2][2][4][2], const pg8::Unit& u, int wr, int wc, int fr, int fq) const {
        const int row0 = u.pm * 256 + wr * 64 + fr, col0 = u.pn * 256 + wc * 32 + 4 * fq;
#pragma unroll
        for (int ai = 0; ai < 2; ++ai) {
            pg8::f32x4 xv[4][2][2];
#pragma unroll
            for (int m = 0; m < 4; ++m)
#pragma unroll
                for (int bj = 0; bj < 2; ++bj)
#pragma unroll
                    for (int n = 0; n < 2; ++n) xv[m][bj][n] = *(const pg8::f32x4*)(X + (size_t)(row0 + ai * 128 + m * 16) * D + col0 + bj * 128 + n * 16);
#pragma unroll
            for (int m = 0; m < 4; ++m)
#pragma unroll
                for (int bj = 0; bj < 2; ++bj)
#pragma unroll
                    for (int n = 0; n < 2; ++n) *(pg8::f32x4*)(O + (size_t)(row0 + ai * 128 + m * 16) * D + col0 + bj * 128 + n * 16) = xv[m][bj][n] + acc[ai][bj][m][n];
        }
        return false;
    }
};
struct EpiSwiGLU {
    static constexpr bool PERM = true;
    bf16* ACT;
    __device__ __forceinline__ bool operator()(pg8::f32x4 (&acc)[2][2][4][2], const pg8::Unit& u, int wr, int wc, int fr_, int fq_) const {
        const int l_ = lane_id_now(); const int fr = l_ & 15, fq = l_ >> 4; (void)fr_; (void)fq_;
        const int row0 = u.pm * 256 + wr * 64 + fr, col0 = u.aux * 128 + wc * 32 + 8 * fq;
#pragma unroll
        for (int ai = 0; ai < 2; ++ai)
#pragma unroll
            for (int m = 0; m < 4; ++m) { bf16* rowp = ACT + (size_t)(row0 + ai * 128 + m * 16) * DFF + col0;
                pg8::f32x4 v0, v1;
#if MOE_FP8
                constexpr float is = 1.f / (SC_W * SC_H);
#pragma unroll
                for (int x = 0; x < 4; ++x) { v0[x] = fast_silu(acc[ai][0][m][0][x] * is) * (acc[ai][1][m][0][x] * (is * SC_A)); v1[x] = fast_silu(acc[ai][0][m][1][x] * is) * (acc[ai][1][m][1][x] * (is * SC_A)); }
                pg8::u32x2 w; w.x = pk4_fp8(v0[0], v0[1], v0[2], v0[3]); w.y = pk4_fp8(v1[0], v1[1], v1[2], v1[3]);
                *(pg8::u32x2*)((unsigned char*)ACT + (size_t)(row0 + ai * 128 + m * 16) * DFF + col0) = w; (void)rowp; }
#else
#pragma unroll
                for (int x = 0; x < 4; ++x) { v0[x] = fast_silu(acc[ai][0][m][0][x]) * acc[ai][1][m][0][x]; v1[x] = fast_silu(acc[ai][0][m][1][x]) * acc[ai][1][m][1][x]; }
                pg8::u32x4 w; w.x = pg8::cvt_pk_bf16(v0[0], v0[1]); w.y = pg8::cvt_pk_bf16(v0[2], v0[3]); w.z = pg8::cvt_pk_bf16(v1[0], v1[1]); w.w = pg8::cvt_pk_bf16(v1[2], v1[3]);
                *(pg8::u32x4*)rowp = w; }
#endif
        return false;
    }
};
struct EpiDown {
    static constexpr bool PERM = true;
    const float* GATEV; bf16* Y;
    __device__ __forceinline__ bool operator()(pg8::f32x4 (&acc)[2][2][4][2], const pg8::Unit& u, int wr, int wc, int fr_, int fq_) const {
        const int l_ = lane_id_now(); const int fr = l_ & 15, fq = l_ >> 4; (void)fr_; (void)fq_;
        const int row0 = u.pm * 256 + wr * 64 + fr, col0 = u.aux * 256 + wc * 32 + 8 * fq;
        float gv[2][4];
#pragma unroll
        for (int ai = 0; ai < 2; ++ai)
#pragma unroll
            for (int m = 0; m < 4; ++m) gv[ai][m] = GATEV[row0 + ai * 128 + m * 16] * (MOE_FP8 ? 1.f / (SC_W * SC_A) : 1.f);
#pragma unroll
        for (int ai = 0; ai < 2; ++ai)
#pragma unroll
            for (int m = 0; m < 4; ++m) { const int row = row0 + ai * 128 + m * 16; const float g = gv[ai][m]; bf16* rowp = Y + (size_t)row * D + col0;
#pragma unroll
                for (int bj = 0; bj < 2; ++bj) { const pg8::f32x4 v0 = acc[ai][bj][m][0] * g, v1 = acc[ai][bj][m][1] * g;
                    pg8::u32x4 w; w.x = pg8::cvt_pk_bf16(v0[0], v0[1]); w.y = pg8::cvt_pk_bf16(v0[2], v0[3]); w.z = pg8::cvt_pk_bf16(v1[0], v1[1]); w.w = pg8::cvt_pk_bf16(v1[2], v1[3]);
                    *(pg8::u32x4*)(rowp + bj * 128) = w; } }
        return false;
    }
};

__device__ __forceinline__ v4u scale_chunk(v4u w, float f) { v4u o; o.x = pk2(bflo(w.x) * f, bfhi(w.x) * f); o.y = pk2(bflo(w.y) * f, bfhi(w.y) * f); o.z = pk2(bflo(w.z) * f, bfhi(w.z) * f); o.w = pk2(bflo(w.w) * f, bfhi(w.w) * f); return o; }
__device__ __forceinline__ size_t qt_index(int br, int dir, int t, int h, int d) { return ((size_t)(br * 2 + dir) * T + t) * QK + h * DK + d; }
__device__ __forceinline__ size_t ab_index(int br, int dir, int b, int h, int n, int d) { return ((((size_t)(br * 2 + dir) * BATCH + b) * NH + h) * NCH + n) * DK + d; }
__device__ __forceinline__ void p2_prep(Frame& F, const Args& A) {
    const bf16* QKR = (const bf16*)(F.ws + WS_QKR); bf16* QT = (bf16*)(F.ws + WS_QT); bf16* KT = (bf16*)(F.ws + WS_KT);
    float* AL = (float*)(F.ws + WS_AL); float* BE = (float*)(F.ws + WS_BE); const float* GA = (const float*)(F.ws + WS_GA);
    const int* POS = (const int*)(const void*)A.in[IN_POS];
    LAS float* gaL = (LAS float*)F.lds;
    LAS float* totL = (LAS float*)(F.lds + 16384);
    LAS float* refL = (LAS float*)(F.lds + 16384 + 4096);
    const float scale = 0.08838834764831845f;
    for (int item = blockIdx.x; item < 2 * BATCH * NH * NCH; item += F.G) {
        const int br = item >> 9, rem = item & 511, b = rem >> 6, h = (rem >> 4) & 3, n = rem & 15, t0 = b * SEQ + n * CH;
        if (br == 0) {
            const float lgf = log_sigmoid(A.in[IN_RDF][h]), lgb = log_sigmoid(A.in[IN_RDB][h]);
            const bf16* Q = QKR; const bf16* Kk = QKR + (size_t)T * QK;
#pragma unroll
            for (int i = 0; i < 2; ++i) {
                const int u = F.tid + 512 * i, j = u >> 3, g = u & 7, d0 = 8 * g, t = t0 + j;
                const float pos = (float)POS[t];
                const v4u q1 = *(const GAS v4u*)(Q + (size_t)t * QK + h * DK + d0), q2 = *(const GAS v4u*)(Q + (size_t)t * QK + h * DK + 64 + d0);
                const v4u k1 = *(const GAS v4u*)(Kk + (size_t)t * QK + h * DK + d0), k2 = *(const GAS v4u*)(Kk + (size_t)t * QK + h * DK + 64 + d0);
                float qa[8], qb[8], ka[8], kb[8];
#pragma unroll
                for (int x = 0; x < 8; ++x) {
                    const unsigned wq1 = q1[x >> 1], wq2 = q2[x >> 1], wk1 = k1[x >> 1], wk2 = k2[x >> 1];
                    const float a1 = (x & 1) ? bfhi(wq1) : bflo(wq1), a2 = (x & 1) ? bfhi(wq2) : bflo(wq2);
                    const float c1 = (x & 1) ? bfhi(wk1) : bflo(wk1), c2 = (x & 1) ? bfhi(wk2) : bflo(wk2);
                    const float invf = __builtin_amdgcn_exp2f(-(float)(d0 + x) * (13.287712379549449f / 64.0f));
                    const float ang = pos * invf; float rev = __builtin_amdgcn_fractf(ang * 0.15915494309189535f); const float sn = __builtin_amdgcn_sinf(rev), cs = __builtin_amdgcn_cosf(rev);
                    qa[x] = (a1 * cs - a2 * sn) * scale; qb[x] = (a2 * cs + a1 * sn) * scale;
                    ka[x] = c1 * cs - c2 * sn; kb[x] = c2 * cs + c1 * sn;
                }
                v4u o;
#define PK8(dst, arr, f) do { dst.x = pk2(arr[0] * (f), arr[1] * (f)); dst.y = pk2(arr[2] * (f), arr[3] * (f)); dst.z = pk2(arr[4] * (f), arr[5] * (f)); dst.w = pk2(arr[6] * (f), arr[7] * (f)); } while (0)
                PK8(o, qa, 1.f); *(GAS v4u*)(QT + qt_index(0, 0, t, h, d0)) = o;
                PK8(o, qb, 1.f); *(GAS v4u*)(QT + qt_index(0, 0, t, h, 64 + d0)) = o;
                PK8(o, ka, 1.f); *(GAS v4u*)(KT + qt_index(0, 0, t, h, d0)) = o;
                PK8(o, kb, 1.f); *(GAS v4u*)(KT + qt_index(0, 0, t, h, 64 + d0)) = o;
#undef PK8
            }
            if (F.tid < 128) { const int d = F.tid;
                AL[ab_index(0, 0, b, h, n, d)] = expf(63.f * lgf); BE[ab_index(0, 0, b, h, n, d)] = expf(65.f * lgf);
                AL[ab_index(0, 1, b, h, n, d)] = expf(63.f * lgb); BE[ab_index(0, 1, b, h, n, d)] = expf(65.f * lgb); }
        } else {
            __syncthreads();
            for (int i = F.tid; i < CH * 32 / 4; i += NTHR) ((LAS f32x4*)gaL)[i] = *(const GAS f32x4*)(GA + (size_t)t0 * 32 + (size_t)i * 4);
            __syncthreads();
            const int lane = F.lane, tok = lane & 15, g4 = lane >> 4, d0 = 16 * F.wave, dq = d0 + 4 * g4;
            const bf16* Q = QKR + (size_t)2 * T * QK; const bf16* Kk = QKR + (size_t)3 * T * QK;
            v2u qv[8], kv[8];
#pragma unroll
            for (int tt = 0; tt < 8; ++tt) { const size_t o = (size_t)(t0 + 16 * tt + tok) * QK + h * DK + dq; qv[tt] = *(const GAS v2u*)(Q + o); kv[tt] = *(const GAS v2u*)(Kk + o); }
#pragma unroll 1
            for (int dir = 0; dir < 2; ++dir) {
                const float* Wg = dir ? A.in[IN_GWB] : A.in[IN_GWF]; const float* Bg = dir ? A.in[IN_GBB] : A.in[IN_GBF];
                bf16x8 a1, a2;
                { float w[8];
#pragma unroll
                  for (int j = 0; j < 8; ++j) w[j] = Wg[(size_t)(8 * (g4 & 1) + j) * QK + h * DK + d0 + tok];
                  unsigned hh[8], ll[8];
#pragma unroll
                  for (int j = 0; j < 8; ++j) { hh[j] = f2bf(w[j]); ll[j] = f2bf(w[j] - bf2f(hh[j])); }
                  v4u hv, lv; hv.x = hh[0] | (hh[1] << 16); hv.y = hh[2] | (hh[3] << 16); hv.z = hh[4] | (hh[5] << 16); hv.w = hh[6] | (hh[7] << 16);
                  lv.x = ll[0] | (ll[1] << 16); lv.y = ll[2] | (ll[3] << 16); lv.z = ll[4] | (ll[5] << 16); lv.w = ll[6] | (ll[7] << 16);
                  if (g4 >= 2) lv = (v4u){0u, 0u, 0u, 0u};
                  a1 = __builtin_bit_cast(bf16x8, hv); a2 = __builtin_bit_cast(bf16x8, lv); }
                const f32x4 bias = *(const GAS f32x4*)(Bg + h * DK + dq);
                f32x4 la[8];
#pragma unroll
                for (int tt = 0; tt < 8; ++tt) {
                    const LAS float* gp = gaL + (16 * tt + tok) * 32 + dir * 16 + 8 * (g4 & 1);
                    const f32x4 g0 = *(const LAS f32x4*)gp, g1 = *(const LAS f32x4*)(gp + 4);
                    v4u gh; gh.x = pk2(g0.x, g0.y); gh.y = pk2(g0.z, g0.w); gh.z = pk2(g1.x, g1.y); gh.w = pk2(g1.z, g1.w);
                    v4u gl; gl.x = pk2(g0.x - bflo(gh.x), g0.y - bfhi(gh.x)); gl.y = pk2(g0.z - bflo(gh.y), g0.w - bfhi(gh.y));
                    gl.z = pk2(g1.x - bflo(gh.z), g1.y - bfhi(gh.z)); gl.w = pk2(g1.z - bflo(gh.w), g1.w - bfhi(gh.w));
                    const v4u z4 = {0u, 0u, 0u, 0u};
                    const bf16x8 b1 = __builtin_bit_cast(bf16x8, g4 < 2 ? gh : gl), b2 = __builtin_bit_cast(bf16x8, g4 < 2 ? gh : z4);
                    f32x4 z = {0.f, 0.f, 0.f, 0.f};
                    z = __builtin_amdgcn_mfma_f32_16x16x32_bf16(a1, b1, z, 0, 0, 0);
                    z = __builtin_amdgcn_mfma_f32_16x16x32_bf16(a2, b2, z, 0, 0, 0);
#pragma unroll
                    for (int r = 0; r < 4; ++r) la[tt][r] = fast_log_sigmoid(z[r] + bias[r]) * (1.0f / 16.0f);
                }
                f32x4 P[8]; f32x4 carry = {0.f, 0.f, 0.f, 0.f};
#pragma unroll
                for (int tt = 0; tt < 8; ++tt) {
                    f32x4 v = la[tt];
#pragma unroll
                    for (int o = 1; o < 16; o <<= 1) {
#pragma unroll
                        for (int r = 0; r < 4; ++r) { const float t = __shfl_up(v[r], o, 16); v[r] += (tok >= o) ? t : 0.f; } }
                    v += carry; P[tt] = v;
#pragma unroll
                    for (int r = 0; r < 4; ++r) carry[r] = __shfl(v[r], 15, 16);
                }
                const f32x4 all = carry;
                f32x4 ref;
                if (dir == 0) {
#pragma unroll
                    for (int r = 0; r < 4; ++r) ref[r] = __shfl(P[4][r], 0, 16);
                } else { const f32x4 s3 = all - P[3] + la[3];
#pragma unroll
                    for (int r = 0; r < 4; ++r) ref[r] = __shfl(s3[r], 15, 16); }
#pragma unroll
                for (int tt = 0; tt < 8; ++tt) {
                    const f32x4 av = dir ? (all - P[tt] + la[tt]) - ref : P[tt] - ref;
                    const int t = t0 + 16 * tt + tok;
                    const v2u qq = qv[tt], kk2 = kv[tt];
                    const float q0 = bflo(qq.x), q1 = bfhi(qq.x), q2 = bflo(qq.y), q3 = bfhi(qq.y), k0 = bflo(kk2.x), k1 = bfhi(kk2.x), k2 = bflo(kk2.y), k3 = bfhi(kk2.y);
                    const float e0 = fexp(av.x), e1 = fexp(av.y), e2 = fexp(av.z), e3 = fexp(av.w), i0 = fexp(-av.x), i1 = fexp(-av.y), i2 = fexp(-av.z), i3 = fexp(-av.w);
                    v2u oq, ok; oq.x = pk2(q0 * scale * e0, q1 * scale * e1); oq.y = pk2(q2 * scale * e2, q3 * scale * e3); ok.x = pk2(k0 * i0, k1 * i1); ok.y = pk2(k2 * i2, k3 * i3);
                    *(GAS v2u*)(QT + qt_index(1, dir, t, h, dq)) = oq; *(GAS v2u*)(KT + qt_index(1, dir, t, h, dq)) = ok;
                }
                if (tok == 0) { f32x4 al, be;
#pragma unroll
                    for (int r = 0; r < 4; ++r) { al[r] = fexp(all[r] - ref[r]); be[r] = fexp(ref[r]); }
                    *(GAS f32x4*)(AL + ab_index(1, dir, b, h, n, dq)) = al; *(GAS f32x4*)(BE + ab_index(1, dir, b, h, n, dq)) = be; }
            }
        }
    }
}

#define MFMA32(a, b, c) __builtin_amdgcn_mfma_f32_32x32x16_bf16((a), (b), (c), 0, 0, 0)
__device__ __forceinline__ bf16x8 frag_kcontig(const bf16* rowbase_k0, int hh) { return *(const GAS bf16x8*)(rowbase_k0 + 8 * hh); }
__device__ __forceinline__ bf16x8 frag_kstrided(const bf16* p, size_t pitch) {
    bf16x8 v;
#pragma unroll
    for (int jj = 0; jj < 8; ++jj) v[jj] = (short)((const GAS bf16*)p)[(size_t)jj * pitch];
    return v;
}

typedef short s16x4 __attribute__((ext_vector_type(4)));
typedef short v4i16_t __attribute__((ext_vector_type(4)));
__device__ __forceinline__ s16x4 vtr(LAS const unsigned char* p) { return __builtin_bit_cast(s16x4, __builtin_amdgcn_ds_read_tr16_b64_v4i16((LAS v4i16_t*)p)); }
__device__ __forceinline__ bf16x8 tr_frag(LAS const unsigned char* p, int pitch) { const s16x4 lo = vtr(p), hi = vtr(p + 4 * pitch); return __builtin_shufflevector(lo, hi, 0, 1, 2, 3, 4, 5, 6, 7); }
__device__ __forceinline__ bf16x8 sw_frag(LAS const unsigned char* tile, int row, int ks, int hh) { return *(const LAS bf16x8*)(tile + row * 256 + (((2 * ks + hh) ^ (row & 15)) << 4)); }

__device__ __forceinline__ size_t rt_index(int br, int dir, int b, int h, int n) { return ((((size_t)(br * 2 + dir) * BATCH + b) * NH + h) * NCH + n) * (size_t)(DV * DK); }
__device__ __forceinline__ void p3_scan(Frame& F, const Args& A) {
    const bf16* KT = (const bf16*)(F.ws + WS_KT); const bf16* V = (const bf16*)(F.ws + WS_V);
    const float* AL = (const float*)(F.ws + WS_AL); const float* BE = (const float*)(F.ws + WS_BE); bf16* RT = (bf16*)(F.ws + WS_RT);
    constexpr int TP = 320;
    LAS unsigned char* Kt = F.lds; LAS unsigned char* Vt = F.lds + 128 * TP;
    constexpr int SP = 272;
    LAS unsigned char* St = F.lds + 2 * 128 * TP;
    LAS float* ALt = (LAS float*)(F.lds + 2 * 128 * TP + 128 * SP);
    LAS float* BEt = (LAS float*)(F.lds + LDSCTL_OFF + 1024);
    static_assert(2 * 128 * TP + 128 * SP + 8192 <= 131072 && LDSCTL_OFF + 1024 + 8192 <= LDS_BYTES, "P3 LDS");
    const int lane = F.lane, r = lane & 31, hh = lane >> 5, blk = (lane >> 4) & 1, q = (lane & 15) >> 2, pp = lane & 3;
    for (int item = blockIdx.x; item < 256; item += F.G) {
        const int br = item >> 7, dir = (item >> 6) & 1, b = (item >> 3) & 7, h = (item >> 1) & 3, eh = item & 1;
        const int dblk = F.wave >> 1, ep = F.wave & 1;
        f32x16 S0, S1;
#pragma unroll
        for (int i = 0; i < 16; ++i) { S0[i] = 0.f; S1[i] = 0.f; }
        const float lgf3 = log_sigmoid(A.in[IN_RDF][h]), lgb3 = log_sigmoid(A.in[IN_RDB][h]);
        v4u preA[8], preB[8];
        int tidv = F.tid; asm volatile("" : "+v"(tidv));
#define P3_CH(st_) (((st_) < NCH ? (st_) : NCH - 1))
#define P3_N(st_) (dir ? NCH - 1 - P3_CH(st_) : P3_CH(st_))
#define P3_LOAD(st_, pre) do { const int t0_ = b * SEQ + P3_N(st_) * CH; _Pragma("unroll") for (int i = 0; i < 8; ++i) { const int c = tidv + 512 * i, tl = c >> 11, row = (c >> 4) & 127, ch = c & 15; \
            const bf16* src = tl ? (V + ((size_t)br * T + t0_ + row) * VD + h * DV + eh * 128 + 8 * ch) : (KT + qt_index(br, br ? dir : 0, t0_ + row, h, 8 * ch)); pre[i] = *(const GAS v4u*)src; } } while (0)
        P3_LOAD(0, preA); P3_LOAD(1, preB);
        __syncthreads();
        { const size_t abi = ab_index(br, dir, b, h, 0, 0);
          ((LAS f32x4*)ALt)[tidv] = *(const GAS f32x4*)(AL + abi + 4 * (size_t)tidv); ((LAS f32x4*)BEt)[tidv] = *(const GAS f32x4*)(BE + abi + 4 * (size_t)tidv); }
#define P3_STEP(st_, pre) do { const int n = P3_N(st_); \
            __syncthreads(); \
            _Pragma("unroll") for (int i = 0; i < 8; ++i) { const int c = tidv + 512 * i, tl = c >> 11, row = (c >> 4) & 127, ch = c & 15; \
                if (tl) *(LAS v4u*)(Vt + row * TP + ch * 16) = pre[i]; \
                else { const int cq = ch & 3, col0 = 32 * (ch >> 2) + 16 * (cq & 1) + 4 * (cq >> 1);     \
                    v4u kv_ = pre[i]; if (br == 0) kv_ = scale_chunk(kv_, fexp(dir ? (float)(row - 63) * lgb3 : (float)(64 - row) * lgf3));     \
                    v2u lo2, hi2; lo2.x = kv_.x; lo2.y = kv_.y; hi2.x = kv_.z; hi2.y = kv_.w;    \
                    *(LAS v2u*)(Kt + row * TP + col0 * 2) = lo2; *(LAS v2u*)(Kt + row * TP + (col0 + 8) * 2) = hi2; } } \
              \
            { const LAS f32x4* bp = (const LAS f32x4*)(BEt + n * 128 + 32 * dblk + 16 * hh); \
              _Pragma("unroll") for (int g = 0; g < 4; ++g) { const f32x4 be = bp[g]; \
                  _Pragma("unroll") for (int x = 0; x < 4; ++x) { S0[4 * g + x] *= be[x]; S1[4 * g + x] *= be[x]; } } } \
            { LAS unsigned char* sp = St + (ep * 64 + r) * SP + 64 * dblk + 32 * hh;                   \
              v4u o; \
              o.x = pk2(S0[0], S0[1]); o.y = pk2(S0[2], S0[3]); o.z = pk2(S0[4], S0[5]); o.w = pk2(S0[6], S0[7]);         *(LAS v4u*)(sp) = o; \
              o.x = pk2(S0[8], S0[9]); o.y = pk2(S0[10], S0[11]); o.z = pk2(S0[12], S0[13]); o.w = pk2(S0[14], S0[15]);   *(LAS v4u*)(sp + 16) = o; \
              o.x = pk2(S1[0], S1[1]); o.y = pk2(S1[2], S1[3]); o.z = pk2(S1[4], S1[5]); o.w = pk2(S1[6], S1[7]);         *(LAS v4u*)(sp + 32 * SP) = o; \
              o.x = pk2(S1[8], S1[9]); o.y = pk2(S1[10], S1[11]); o.z = pk2(S1[12], S1[13]); o.w = pk2(S1[14], S1[15]);   *(LAS v4u*)(sp + 32 * SP + 16) = o; } \
            __syncthreads(); \
            P3_LOAD((st_) + 2, pre);                            \
            { bf16* rt = RT + rt_index(br, dir, b, h, n) + (size_t)(eh * 128) * DK; \
              _Pragma("unroll") for (int i = 0; i < 4; ++i) { const int c = tidv + 512 * i, row = c >> 4, ch = c & 15; \
                  *(GAS v4u*)(rt + (size_t)row * DK + 8 * ch) = *(const LAS v4u*)(St + row * SP + ch * 16); } } \
              \
            { const LAS unsigned char* ka = Kt + (8 * hh + q) * TP + (32 * dblk + 16 * blk + 4 * pp) * 2; \
              const LAS unsigned char* vb = Vt + (8 * hh + q) * TP + (ep * 64 + 16 * blk + 4 * pp) * 2; \
              _Pragma("unroll") for (int ks = 0; ks < 8; ++ks) { \
                const bf16x8 a = tr_frag(ka + ks * 16 * TP, TP); \
                const bf16x8 b0 = tr_frag(vb + ks * 16 * TP, TP), b1 = tr_frag(vb + 64 + ks * 16 * TP, TP); \
                S0 = MFMA32(a, b0, S0); S1 = MFMA32(a, b1, S1); } } \
            { const LAS f32x4* ap = (const LAS f32x4*)(ALt + n * 128 + 32 * dblk + 16 * hh); \
              _Pragma("unroll") for (int g = 0; g < 4; ++g) { const f32x4 al = ap[g]; \
                  _Pragma("unroll") for (int x = 0; x < 4; ++x) { S0[4 * g + x] *= al[x]; S1[4 * g + x] *= al[x]; } } } \
        } while (0)
#pragma unroll 1
        for (int step = 0; step < NCH; step += 2) { P3_STEP(step, preA); P3_STEP(step + 1, preB); }
#undef P3_STEP
#undef P3_LOAD
#undef P3_N
#undef P3_CH
    }
}

__device__ __forceinline__ void p4_chunk(Frame& F, const Args& A) {
    const bf16* QT = (const bf16*)(F.ws + WS_QT); const bf16* KT = (const bf16*)(F.ws + WS_KT); const bf16* V = (const bf16*)(F.ws + WS_V);
    const bf16* RT = (const bf16*)(F.ws + WS_RT); const bf16* Gt = (const bf16*)(F.ws + WS_G); bf16* RO = (bf16*)(F.ws + WS_RO);
    constexpr int VP = 576;
    constexpr int NITEM = 2 * BATCH * NH * NCH;
    LAS unsigned char* L = F.lds;
    LAS float* ST = (LAS float*)(F.lds + LDSCTL_OFF + 1024);
    const int ib = F.wave & 3, eh = F.wave >> 2;
    v4u pre1[8];
#define P4_LOAD1(it_, dst_, i0_) do { const int br_ = (it_) >> 9, rem_ = (it_) & 511, b_ = rem_ >> 6, h_ = (rem_ >> 4) & 3, n_ = rem_ & 15, t0_ = b_ * SEQ + n_ * CH; \
        int tv_ = F.tid; asm volatile("" : "+v"(tv_)); \
        _Pragma("unroll") for (int i = 0; i < 8; ++i) { const int c = tv_ + 512 * (i + (i0_)), tl = c >> 11, row = (c >> 4) & 127, ch = c & 15; \
            dst_[i] = *(const GAS v4u*)((tl < 2 ? KT : QT) + qt_index(br_, br_ ? (tl & 1) : 0, t0_ + row, h_, 8 * ch)); } } while (0)
    int item = blockIdx.x;
    P4_LOAD1(item < NITEM ? item : 0, pre1, 0);
    for (; item < NITEM; item += F.G) {
        const int br = item >> 9, rem = item & 511, b = rem >> 6, h = (rem >> 4) & 3, n = rem & 15, t0 = b * SEQ + n * CH;
        int tidv = F.tid; asm volatile("" : "+v"(tidv));
        const float lgf4 = log_sigmoid(A.in[IN_RDF][h]), lgb4 = log_sigmoid(A.in[IN_RDB][h]);
        const int lane = tidv & 63, r = lane & 31, hh = lane >> 5, blk = (lane >> 4) & 1, q = (lane & 15) >> 2, pp = lane & 3;
        __syncthreads();
        { v4u pre2[8]; P4_LOAD1(item, pre2, 8);
#pragma unroll
          for (int i = 0; i < 8; ++i) { const int c = tidv + 512 * i, tl = c >> 11, row = (c >> 4) & 127, ch = c & 15;
              v4u w_ = pre1[i]; if (br == 0) w_ = scale_chunk(w_, fexp(tl ? (float)(row - 63) * lgb4 : (float)(64 - row) * lgf4));
              *(LAS v4u*)(L + tl * 32768 + row * 256 + ((ch ^ (row & 15)) << 4)) = w_; }
#pragma unroll
          for (int i = 0; i < 8; ++i) { const int c = tidv + 512 * (i + 8), tl = c >> 11, row = (c >> 4) & 127, ch = c & 15;
              v4u w_ = pre2[i]; if (br == 0) w_ = scale_chunk(w_, fexp(tl == 3 ? (float)(63 - row) * lgb4 : (float)(row - 64) * lgf4));
              *(LAS v4u*)(L + tl * 32768 + row * 256 + ((ch ^ (row & 15)) << 4)) = w_; } }
        __syncthreads();
        const int rowq = 32 * ib + r;
        bf16x8 qf[8], qb[8];
#pragma unroll
        for (int ks = 0; ks < 8; ++ks) { qf[ks] = sw_frag(L + 2 * 32768, rowq, ks, hh); qb[ks] = sw_frag(L + 3 * 32768, rowq, ks, hh); }
        v4u preV[8];
#pragma unroll
        for (int i = 0; i < 8; ++i) { const int c = tidv + 512 * i, row = c >> 5, ch = c & 31; preV[i] = *(const GAS v4u*)(V + ((size_t)br * T + t0 + row) * VD + h * DV + 8 * ch); }
        v2u pk[2][4];
#pragma unroll
        for (int jj2 = 0; jj2 < 2; ++jj2) {
            const int jb = 2 * eh + jj2, rowk = 32 * jb + r;
            f32x16 sf, sb;
#pragma unroll
            for (int i = 0; i < 16; ++i) { sf[i] = 0.f; sb[i] = 0.f; }
            if (jb <= ib) {
#pragma unroll
                for (int ks = 0; ks < 8; ++ks) sf = MFMA32(sw_frag(L, rowk, ks, hh), qf[ks], sf); }
            if (jb >= ib) {
#pragma unroll
                for (int ks = 0; ks < 8; ++ks) sb = MFMA32(sw_frag(L + 32768, rowk, ks, hh), qb[ks], sb); }
#pragma unroll
            for (int g = 0; g < 4; ++g) {
                const int j0 = 32 * jb + 8 * g + 4 * hh;
                float pv[4];
#pragma unroll
                for (int x = 0; x < 4; ++x) pv[x] = (j0 + x <= rowq) ? sf[4 * g + x] : sb[4 * g + x];
                pk[jj2][g].x = pk2(pv[0], pv[1]); pk[jj2][g].y = pk2(pv[2], pv[3]);
            }
        }
        __syncthreads();
#pragma unroll
        for (int jj2 = 0; jj2 < 2; ++jj2)
#pragma unroll
            for (int g = 0; g < 4; ++g) { const int jb = 2 * eh + jj2; *(LAS v2u*)(L + rowq * 256 + (((4 * jb + g) ^ (rowq & 15)) << 4) + 8 * hh) = pk[jj2][g]; }
#pragma unroll
        for (int i = 0; i < 8; ++i) { const int c = tidv + 512 * i, row = c >> 5, ch = c & 31; *(LAS v4u*)(L + 32768 + row * VP + ch * 16) = preV[i]; }
        __syncthreads();
        f32x16 acc[4];
#pragma unroll
        for (int c = 0; c < 4; ++c)
#pragma unroll
            for (int i = 0; i < 16; ++i) acc[c][i] = 0.f;
        const int ebase = eh * 128;
        { const LAS unsigned char* va = L + 32768 + (8 * hh + q) * VP + (ebase + 16 * blk + 4 * pp) * 2;
#pragma unroll
          for (int ks = 0; ks < 8; ++ks) {
            const bf16x8 pb = sw_frag(L, rowq, ks, hh);
#pragma unroll
            for (int c = 0; c < 4; ++c) acc[c] = MFMA32(tr_frag(va + ks * 16 * VP + c * 64, VP), pb, acc[c]);
            __builtin_amdgcn_sched_barrier(0);
          } }
        __syncthreads();
        v4u preR[8];
#pragma unroll
        for (int i = 0; i < 8; ++i) { const int c = tidv + 512 * i, row = c >> 4, ch = c & 15; preR[i] = *(const GAS v4u*)(RT + rt_index(br, 0, b, h, n) + (size_t)row * DK + 8 * ch); }
#pragma unroll
        for (int i = 0; i < 8; ++i) { const int c = tidv + 512 * i, row = c >> 4, ch = c & 15; *(LAS v4u*)(L + row * 256 + ((ch ^ (row & 15)) << 4)) = preR[i]; }
#pragma unroll
        for (int i = 0; i < 8; ++i) { const int c = tidv + 512 * i, row = c >> 4, ch = c & 15; preR[i] = *(const GAS v4u*)(RT + rt_index(br, 1, b, h, n) + (size_t)row * DK + 8 * ch); }
        __syncthreads();
#pragma unroll
        for (int ks = 0; ks < 8; ++ks) {
#pragma unroll
            for (int c = 0; c < 4; ++c) acc[c] = MFMA32(sw_frag(L, ebase + 32 * c + r, ks, hh), qf[ks], acc[c]);
            __builtin_amdgcn_sched_barrier(0); }
#pragma unroll
        for (int i = 0; i < 8; ++i) { const int c = tidv + 512 * i, row = c >> 4, ch = c & 15; *(LAS v4u*)(L + 65536 + row * 256 + ((ch ^ (row & 15)) << 4)) = preR[i]; }
        v4u gtv[8];
#pragma unroll
        for (int i = 0; i < 8; ++i) { const int c = tidv + 512 * i, row = c >> 5, ch = c & 31; gtv[i] = *(const GAS v4u*)(Gt + ((size_t)br * T + t0 + row) * VD + h * DV + 8 * ch); }
        __syncthreads();
#pragma unroll
        for (int ks = 0; ks < 8; ++ks) {
#pragma unroll
            for (int c = 0; c < 4; ++c) acc[c] = MFMA32(sw_frag(L + 65536, ebase + 32 * c + r, ks, hh), qb[ks], acc[c]);
            __builtin_amdgcn_sched_barrier(0); }
        float s1 = 0.f, s2 = 0.f;
#pragma unroll
        for (int c = 0; c < 4; ++c)
#pragma unroll
            for (int i = 0; i < 16; ++i) { s1 += acc[c][i]; s2 += acc[c][i] * acc[c][i]; }
        s1 += __shfl_xor(s1, 32); s2 += __shfl_xor(s2, 32);
        if (hh == 0) { ST[((ib * 2 + eh) * 32 + r) * 2] = s1; ST[((ib * 2 + eh) * 32 + r) * 2 + 1] = s2; }
        __syncthreads();
        const float o1 = ST[((ib * 2 + (eh ^ 1)) * 32 + r) * 2], o2 = ST[((ib * 2 + (eh ^ 1)) * 32 + r) * 2 + 1];
        s1 += o1; s2 += o2;
        float mu, rstd;
        if (br == 0) { mu = s1 * (1.f / DV); const float var = fmaxf(s2 * (1.f / DV) - mu * mu, 0.f); rstd = 1.f / sqrtf(var + EPS); }
        else         { mu = 0.f; rstd = 1.f / sqrtf(s2 * (1.f / DV) + EPS); }
        const float* nw = (br == 0 ? A.in[IN_RET_NORM] : A.in[IN_GLA_NORM]) + h * DV;
#pragma unroll
        for (int c = 0; c < 4; ++c)
#pragma unroll
            for (int g = 0; g < 4; ++g) {
                const int e = ebase + 32 * c + 8 * g + 4 * hh;
                const f32x4 w = *(const GAS f32x4*)(nw + e);
                v2u o; o.x = pk2((acc[c][4 * g] - mu) * rstd * w.x, (acc[c][4 * g + 1] - mu) * rstd * w.y); o.y = pk2((acc[c][4 * g + 2] - mu) * rstd * w.z, (acc[c][4 * g + 3] - mu) * rstd * w.w);
                *(LAS v2u*)(L + rowq * 512 + ((((e >> 3)) ^ (rowq & 15)) << 4) + (e & 4) * 2) = o;
            }
        __syncthreads();
        { const int nx_ = item + (int)F.G; P4_LOAD1(nx_ < NITEM ? nx_ : item, pre1, 0); }
        {
#pragma unroll
          for (int i = 0; i < 8; ++i) { const int c = tidv + 512 * i, row = c >> 5, ch = c & 31;
            const v4u y = *(const LAS v4u*)(L + row * 512 + ((ch ^ (row & 15)) << 4));
            const size_t go = ((size_t)br * T + t0 + row) * VD + h * DV + 8 * ch;
            const v4u gt = gtv[i];
            v4u o; o.x = pk2(bflo(y.x) * bflo(gt.x), bfhi(y.x) * bfhi(gt.x)); o.y = pk2(bflo(y.y) * bflo(gt.y), bfhi(y.y) * bfhi(gt.y));
            o.z = pk2(bflo(y.z) * bflo(gt.z), bfhi(y.z) * bfhi(gt.z)); o.w = pk2(bflo(y.w) * bflo(gt.w), bfhi(y.w) * bfhi(gt.w));
            *(GAS v4u*)(RO + go) = o; } }
    }
#undef P4_LOAD1
}

__device__ __forceinline__ void p7_router(Frame& F, const Args& A) {
    LAS unsigned char* WH = F.lds;
    LAS unsigned char* WL = F.lds + 32768;
    LAS float* GL = (LAS float*)(F.lds + 65536);
    LAS float* ssX = (LAS float*)(F.lds + 69632);
    LAS f32x4* lgX = (LAS f32x4*)(F.lds + 69632 + 512);
    { const float* wr = A.in[IN_W_ROUTER]; const float* gn = A.in[IN_NORM_FFN];
#pragma unroll
      for (int i = 0; i < 4; ++i) { const int x = F.tid + 512 * i, e = x & 15, kg = (x >> 4) & 3, S = x >> 6, k0 = 32 * S + 8 * kg;
          float w[8];
#pragma unroll
          for (int j = 0; j < 8; ++j) w[j] = wr[(size_t)(k0 + j) * NE + e] * gn[k0 + j];
          unsigned h[8], l[8];
#pragma unroll
          for (int j = 0; j < 8; ++j) { h[j] = f2bf(w[j]); l[j] = f2bf(w[j] - bf2f(h[j])); }
          v4u hv, lv; hv.x = h[0] | (h[1] << 16); hv.y = h[2] | (h[3] << 16); hv.z = h[4] | (h[5] << 16); hv.w = h[6] | (h[7] << 16);
          lv.x = l[0] | (l[1] << 16); lv.y = l[2] | (l[3] << 16); lv.z = l[4] | (l[5] << 16); lv.w = l[6] | (l[7] << 16);
          *(LAS v4u*)(WH + x * 16) = hv; *(LAS v4u*)(WL + x * 16) = lv; }
      if (F.tid < 256) *((LAS f32x4*)GL + F.tid) = *((const GAS f32x4*)gn + F.tid); }
    __syncthreads();
    unsigned char* H2 = (unsigned char*)(F.ws + WS_H2); float* AFF = (float*)(F.ws + WS_AFF);
    static_assert(MOE_FP8 == 1, "P7 writes fp8 rows");
    const int lane = F.lane, tok = lane & 15, kg = lane >> 4, kh = F.wave & 1;
    for (int tile0 = F.vcu * 4; tile0 < T / 16; tile0 += 4 * F.G) {
        const int m = 16 * (tile0 + (F.wave >> 1)) + tok;
        const GAS f32x4* xr = (const GAS f32x4*)(F.out + (size_t)m * D + kh * 512 + 8 * kg);
        f32x4 v[32];
#pragma unroll
        for (int s2 = 0; s2 < 16; ++s2) { v[2 * s2] = xr[8 * s2]; v[2 * s2 + 1] = xr[8 * s2 + 1]; }
        f32x4 acc = {0.f, 0.f, 0.f, 0.f}; float ss = 0.f;
        LAS const unsigned char* whp = WH + ((kh * 16 * 4 + kg) * 16 + tok) * 16; LAS const unsigned char* wlp = WL + ((kh * 16 * 4 + kg) * 16 + tok) * 16;
        asm volatile("" : "+v"(whp), "+v"(wlp));
#pragma unroll
        for (int s2 = 0; s2 < 16; ++s2) {
            const f32x4 a = v[2 * s2], c = v[2 * s2 + 1];
            ss += (a.x * a.x + a.y * a.y) + (a.z * a.z + a.w * a.w) + (c.x * c.x + c.y * c.y) + (c.z * c.z + c.w * c.w);
            v4u xh; xh.x = pk2(a.x, a.y); xh.y = pk2(a.z, a.w); xh.z = pk2(c.x, c.y); xh.w = pk2(c.z, c.w);
            v4u xl; xl.x = pk2(a.x - bflo(xh.x), a.y - bfhi(xh.x)); xl.y = pk2(a.z - bflo(xh.y), a.w - bfhi(xh.y));
            xl.z = pk2(c.x - bflo(xh.z), c.y - bfhi(xh.z)); xl.w = pk2(c.z - bflo(xh.w), c.w - bfhi(xh.w));
            const bf16x8 wh = *(const LAS bf16x8*)(whp + s2 * 1024), wl = *(const LAS bf16x8*)(wlp + s2 * 1024);
            const bf16x8 bh = __builtin_bit_cast(bf16x8, xh), bl = __builtin_bit_cast(bf16x8, xl);
            acc = __builtin_amdgcn_mfma_f32_16x16x32_bf16(wh, bh, acc, 0, 0, 0);
            acc = __builtin_amdgcn_mfma_f32_16x16x32_bf16(wh, bl, acc, 0, 0, 0);
            acc = __builtin_amdgcn_mfma_f32_16x16x32_bf16(wl, bh, acc, 0, 0, 0);
            if ((s2 & 3) == 3) __builtin_amdgcn_sched_barrier(0);
        }
        ss += __shfl_xor(ss, 16); ss += __shfl_xor(ss, 32);
        __syncthreads();
        if (kg == 0) ssX[F.wave * 16 + tok] = ss;
        lgX[F.wave * 64 + lane] = acc;
        __syncthreads();
        const float rstd = 1.f / sqrtf((ss + ssX[(F.wave ^ 1) * 16 + tok]) * (1.f / D) + EPS);
        { GAS v2u* o8 = (GAS v2u*)(H2 + (size_t)m * D + kh * 512 + 8 * kg); LAS const f32x4* gp = (LAS const f32x4*)(GL + kh * 512 + 8 * kg);
          const float sc = rstd * SC_H;
#pragma unroll
          for (int s2 = 0; s2 < 16; ++s2) { const f32x4 g0 = gp[8 * s2], g1 = gp[8 * s2 + 1]; const f32x4 a = v[2 * s2], c = v[2 * s2 + 1];
              v2u o; o.x = pk4_fp8(a.x * sc * g0.x, a.y * sc * g0.y, a.z * sc * g0.z, a.w * sc * g0.w); o.y = pk4_fp8(c.x * sc * g1.x, c.y * sc * g1.y, c.z * sc * g1.z, c.w * sc * g1.w);
              o8[4 * s2] = o; } }
        if (kh == 0) {
            const f32x4 o = lgX[(F.wave ^ 1) * 64 + lane];
            f32x4 lg; lg.x = (acc.x + o.x) * rstd; lg.y = (acc.y + o.y) * rstd; lg.z = (acc.z + o.z) * rstd; lg.w = (acc.w + o.w) * rstd;
            float mx = fmaxf(fmaxf(lg.x, lg.y), fmaxf(lg.z, lg.w)); mx = fmaxf(mx, __shfl_xor(mx, 16)); mx = fmaxf(mx, __shfl_xor(mx, 32));
            f32x4 ex; ex.x = expf(lg.x - mx); ex.y = expf(lg.y - mx); ex.z = expf(lg.z - mx); ex.w = expf(lg.w - mx);
            float sum = (ex.x + ex.y) + (ex.z + ex.w); sum += __shfl_xor(sum, 16); sum += __shfl_xor(sum, 32);
            const float inv = 1.f / sum; const int b = m >> 11, sidx = m & (SEQ - 1);
            float* ap = AFF + ((size_t)b * NE + 4 * kg) * SEQ + sidx;
            ap[0] = ex.x * inv; ap[SEQ] = ex.y * inv; ap[2 * SEQ] = ex.z * inv; ap[3 * SEQ] = ex.w * inv;
        }
    }
}

__device__ __forceinline__ int block_excl_scan(int v, LAS int* wsum, int wave, int lane, int& total) {
    int inc = v;
#pragma unroll
    for (int o = 1; o < 64; o <<= 1) { const int t = __shfl_up(inc, o); if (lane >= o) inc += t; }
    __syncthreads();
    if (lane == 63) wsum[wave] = inc;
    __syncthreads();
    int off = 0, tot = 0;
#pragma unroll
    for (int w = 0; w < NWAVES; ++w) { const int x = wsum[w]; off += (w < wave) ? x : 0; tot += x; }
    total = tot; return off + inc - v;
}
__device__ __forceinline__ void p8_topk(Frame& F, const Args& A) {
    const float* AFF = (const float*)(F.ws + WS_AFF); int* RK = (int*)(F.ws + WS_RK); float* GATEV = (float*)(F.ws + WS_GATEV);
    const bf16* H2 = (const bf16*)(F.ws + WS_H2); bf16* XG = (bf16*)(F.ws + WS_XG);
    LAS int* sel = (LAS int*)(F.lds + 69632);
    LAS int* cntL = (LAS int*)(F.lds + 69632 + 1024);
    LAS int* wsum = (LAS int*)(F.lds + 69632 + 2048);
    for (int item2 = blockIdx.x; item2 < 2 * BATCH * NE; item2 += F.G) {
        const int item = item2 & (BATCH * NE - 1), half = item2 >> 7;
        const int b = item >> 4, e = item & 15;
        __syncthreads();
        if (F.tid < 64) cntL[F.tid] = 0;
        const v4u k4 = *(const GAS v4u*)(AFF + ((size_t)b * NE + e) * SEQ + 4 * F.tid);
        const unsigned kk[4] = {k4.x, k4.y, k4.z, k4.w};
        __syncthreads();
        unsigned lo = 0u, hi = 0x3F800001u; int it = 0;
        while (hi - lo > 1u) {
            const unsigned q = (hi - lo + 3u) >> 2;
            const unsigned m1 = lo + q, m2 = (lo + 2u * q < hi) ? lo + 2u * q : hi, m3 = (lo + 3u * q < hi) ? lo + 3u * q : hi;
            const int c1 = __popcll(__ballot(k4.x >= m1)) + __popcll(__ballot(k4.y >= m1)) + __popcll(__ballot(k4.z >= m1)) + __popcll(__ballot(k4.w >= m1));
            const int c2 = __popcll(__ballot(k4.x >= m2)) + __popcll(__ballot(k4.y >= m2)) + __popcll(__ballot(k4.z >= m2)) + __popcll(__ballot(k4.w >= m2));
            const int c3 = __popcll(__ballot(k4.x >= m3)) + __popcll(__ballot(k4.y >= m3)) + __popcll(__ballot(k4.z >= m3)) + __popcll(__ballot(k4.w >= m3));
            if (F.lane < 3) __hip_atomic_fetch_add(&cntL[3 * it + F.lane], F.lane == 0 ? c1 : (F.lane == 1 ? c2 : c3), __ATOMIC_RELAXED, __HIP_MEMORY_SCOPE_WORKGROUP);
            __syncthreads();
            const int t1 = cntL[3 * it], t2 = cntL[3 * it + 1], t3 = cntL[3 * it + 2];
            if (t3 >= CAP) lo = m3; else if (t2 >= CAP) { lo = m2; hi = m3; } else if (t1 >= CAP) { lo = m1; hi = m2; } else hi = m1;
            ++it;
        }
        const unsigned thr = lo;
        int ngt_tot, eq_tot;
        const int ngt = (k4.x > thr) + (k4.y > thr) + (k4.z > thr) + (k4.w > thr);
        const int neq = (k4.x == thr) + (k4.y == thr) + (k4.z == thr) + (k4.w == thr);
        (void)block_excl_scan(ngt, wsum, F.wave, F.lane, ngt_tot);
        int eqpre = block_excl_scan(neq, wsum, F.wave, F.lane, eq_tot);
        const int need = CAP - ngt_tot;
        int f[4]; int nsel = 0;
#pragma unroll
        for (int x = 0; x < 4; ++x) { const unsigned k = kk[x]; const bool iseq = (k == thr); f[x] = (k > thr) || (iseq && eqpre < need); eqpre += iseq ? 1 : 0; nsel += f[x]; }
        int sel_tot; int slot = block_excl_scan(nsel, wsum, F.wave, F.lane, sel_tot);
#pragma unroll
        for (int x = 0; x < 4; ++x) { const int i = 4 * F.tid + x;
            if (half == 0) RK[((size_t)b * SEQ + i) * NE + e] = f[x] ? slot : 0x7fffffff;
            if (f[x]) { sel[slot] = i; if (half == 0) GATEV[(size_t)e * EROWS + b * CAP + slot] = __builtin_bit_cast(float, kk[x]); ++slot; } }
        __syncthreads();
        constexpr int RB = MOE_FP8 ? D : 2 * D, CPR = RB / 16, LCPR = MOE_FP8 ? 6 : 7;
        for (int c0 = half * (CAP / 2) * CPR; c0 < (half + 1) * (CAP / 2) * CPR; c0 += NTHR * 8) {
            v4u tmp[8];
#pragma unroll
            for (int u = 0; u < 8; ++u) { const int c = c0 + u * NTHR + F.tid, sl = c >> LCPR, ch = c & (CPR - 1); tmp[u] = *((const GAS v4u*)((const unsigned char*)H2 + ((size_t)b * SEQ + sel[sl]) * RB) + ch); }
#pragma unroll
            for (int u = 0; u < 8; ++u) { const int c = c0 + u * NTHR + F.tid, sl = c >> LCPR, ch = c & (CPR - 1); *((GAS v4u*)((unsigned char*)XG + ((size_t)e * EROWS + b * CAP + sl) * RB) + ch) = tmp[u]; }
        }
    }
    const int gw = F.vcu * NWAVES + F.wave, NGW = F.G * NWAVES;
    if (F.G == 256) {
        unsigned base = __hip_atomic_load((gu32*)(F.ws + WS_CTL) + CW_CONVQ, RLX_AGENT); base = __builtin_amdgcn_readfirstlane(base);
        if (base > (unsigned)Q_P1) base = (unsigned)Q_P1;
        if (base < (unsigned)Q_N) y_range(F, A, (int)base + gw, Q_N, NGW);
    }
}

__device__ __forceinline__ void p11_final(Frame& F, const Args& A) {
    const int gw = F.vcu * NWAVES + F.wave, NGW = F.G * NWAVES, lane = F.lane;
    const int* RK = (const int*)(F.ws + WS_RK); const bf16* Y = (const bf16*)(F.ws + WS_Y);
    f32x4 gn[4];
#pragma unroll
    for (int j = 0; j < 4; ++j) gn[j] = *((const GAS f32x4*)A.in[IN_NORM_FINAL] + lane + 64 * j);
    int rkn = (gw < T && lane < NE) ? RK[(size_t)gw * NE + lane] : 0x7fffffff;
    for (int m = gw; m < T; m += NGW) {
        GAS f32x4* xr = (GAS f32x4*)(F.out + (size_t)m * D) + lane;
        GAS f32x4* xw = A.dup ? (GAS f32x4*)((float*)(F.ws + WS_R1) + (size_t)m * D) + lane : xr;
        f32x4 v[4];
#pragma unroll
        for (int j = 0; j < 4; ++j) v[j] = xr[64 * j];
        const int rkv = rkn;
        { const int mn = m + NGW; rkn = (mn < T && lane < NE) ? RK[(size_t)mn * NE + lane] : 0x7fffffff; }
        const int b = m >> 11;
        unsigned long long mask = __ballot(rkv < CAP);
        while (mask) {
            const int e0 = __builtin_ctzll(mask); mask &= mask - 1;
            const bool two = mask != 0ull; const int e1 = two ? __builtin_ctzll(mask) : e0; if (two) mask &= mask - 1;
            const int r0 = __builtin_amdgcn_readlane(rkv, e0), r1 = __builtin_amdgcn_readlane(rkv, e1);
            const GAS v2u* y0 = (const GAS v2u*)(Y + ((size_t)e0 * EROWS + b * CAP + r0) * D) + lane;
            const GAS v2u* y1 = (const GAS v2u*)(Y + ((size_t)e1 * EROWS + b * CAP + r1) * D) + lane;
            v2u w0[4], w1[4];
#pragma unroll
            for (int j = 0; j < 4; ++j) { w0[j] = y0[64 * j]; w1[j] = y1[64 * j]; }
            const float s1 = two ? 1.f : 0.f;
#pragma unroll
            for (int j = 0; j < 4; ++j) { v[j].x += bflo(w0[j].x) + s1 * bflo(w1[j].x); v[j].y += bfhi(w0[j].x) + s1 * bfhi(w1[j].x); v[j].z += bflo(w0[j].y) + s1 * bflo(w1[j].y); v[j].w += bfhi(w0[j].y) + s1 * bfhi(w1[j].y); }
        }
        float s = 0.f;
#pragma unroll
        for (int j = 0; j < 4; ++j) s += (v[j].x * v[j].x + v[j].y * v[j].y) + (v[j].z * v[j].z + v[j].w * v[j].w);
        const float rstd = 1.f / sqrtf(wave_sum(s) * (1.f / D) + EPS);
#pragma unroll
        for (int j = 0; j < 4; ++j) xw[64 * j] = v[j] * rstd * gn[j];
    }
}

__global__ void __launch_bounds__(NTHR, 2) mega_fwd(Args args) {
    extern __shared__ __attribute__((aligned(16))) unsigned char lds[];
    Frame F;
    F.lds = (LAS unsigned char*)lds;
    F.tid = threadIdx.x; F.lane = F.tid & 63; F.wave = __builtin_amdgcn_readfirstlane(F.tid >> 6);
    F.G = args.grid; { const int bx = blockIdx.x; F.vcu = (F.G % 8 == 0) ? (bx % 8) * (F.G / 8) + bx / 8 : bx; }
    F.out = args.out; F.ws = args.ws;
    volatile LAS unsigned* MISC = (volatile LAS unsigned*)(F.lds + MISC_OFF);
    for (int u = F.tid; u < (LDS_BYTES - LDSCTL_OFF) / 4; u += NTHR) ((LAS unsigned*)(F.lds + LDSCTL_OFF))[u] = 0u;
    __syncthreads();
    const int lo = args.ph_lo, hi = args.ph_hi;
    XcdBarrier bar; bar.bar = (unsigned*)(F.ws + WS_CTL) + CW_BAR; bar.x = 0; bar.st = nullptr; bar.G = 0; bar.wave = F.wave;
    if (hi - lo > 1) bar = xcd_barrier_post((unsigned*)(F.ws + WS_CTL) + CW_BAR, MISC + 8, F.wave);
#define IN(k) (lo <= (k) && (k) < hi)
#define SEAM(k) do { if (IN(k) && IN((k) + 1)) xcd_barrier(bar, (unsigned)args.grid); } while (0)

#define REFRAME() do { F.lane = lane_id_now(); F.tid = F.wave * 64 + F.lane; } while (0)
    if (IN(0)) { REFRAME(); p0_prologue(F, args); } SEAM(0);
    if (IN(1)) {
        const bool split = (F.G == 256); const int ng = split ? NG1 : F.G;
        if ((int)blockIdx.x < ng) {
            SchedPlain S{T / 256, DINP / 256, ng, (int)blockIdx.x, (const bf16*)(F.ws + WS_XN), (const bf16*)(F.ws + WS_WIN), split ? (gu32*)(F.ws + WS_CTL) + CW_DONE : (gu32*)nullptr};
            EpiInProj E{(bf16*)(F.ws + WS_QKR), (bf16*)(F.ws + WS_V), (bf16*)(F.ws + WS_G), (bf16*)F.out, (float*)(F.ws + WS_GA)};
            pg8::gemm_phase<D, EpiInProj, SchedPlain, true, true>(F.lds, S, E, F.wave);
        }
        if (split) { REFRAME(); p1_stream(F, args); }
    } SEAM(1);
    if (IN(2)) { REFRAME(); p2_prep(F, args); } SEAM(2);
    if (IN(3)) { REFRAME(); p3_scan(F, args); } SEAM(3);
    if (IN(4)) { REFRAME(); p4_chunk(F, args); } SEAM(4);
    if (IN(5)) {
        SchedBranch S{F.G, (int)blockIdx.x, (const bf16*)(F.ws + WS_RO), (const bf16*)(F.ws + WS_RO) + (size_t)T * VD, (const bf16*)(F.ws + WS_WBR), (const bf16*)(F.ws + WS_WBG)};
        EpiBranch E{(const bf16*)F.out, (bf16*)(F.ws + WS_MERGED)};
        pg8::gemm_phase<D, EpiBranch, SchedBranch, true, true>(F.lds, S, E, F.wave);
    } SEAM(5);
    if (IN(6)) {
        SchedPlain S{T / 256, D / 256, F.G, (int)blockIdx.x, (const bf16*)(F.ws + WS_MERGED), (const bf16*)(F.ws + WS_WOUT), (gu32*)nullptr};
        EpiOut E{args.in[IN_X], F.out};
        pg8::gemm_phase<D, EpiOut, SchedPlain, true, true>(F.lds, S, E, F.wave);
    } SEAM(6);
    if (IN(7)) { REFRAME(); p7_router(F, args); } SEAM(7);
    if (IN(8)) { REFRAME(); p8_topk(F, args); } SEAM(8);
    if (IN(9)) {
        SchedMoe S{2 * DFF / 256, F.G, (int)blockIdx.x, (const bf16*)(F.ws + WS_XG), (const bf16*)(F.ws + WS_WGU)};
        EpiSwiGLU E{(bf16*)(F.ws + WS_ACT)};
        pg8::gemm_phase<(MOE_FP8 ? D / 2 : D), EpiSwiGLU, SchedMoe, true, true, MOE_FP8 != 0>(F.lds, S, E, F.wave);
    } SEAM(9);
    if (IN(10)) {
        SchedMoe S{D / 256, F.G, (int)blockIdx.x, (const bf16*)(F.ws + WS_ACT), (const bf16*)(F.ws + WS_WDN)};
        EpiDown E{(const float*)(F.ws + WS_GATEV), (bf16*)(F.ws + WS_Y)};
        pg8::gemm_phase<(MOE_FP8 ? DFF / 2 : DFF), EpiDown, SchedMoe, true, true, MOE_FP8 != 0>(F.lds, S, E, F.wave);
    } SEAM(10);
    if (IN(11)) { REFRAME(); p11_final(F, args); }
#undef REFRAME
#undef IN
#undef SEAM
}

extern "C" void kernel_launch(void* const* d_in, const int* in_sizes, int n_in, void* d_out, int out_size, void* d_ws, size_t ws_size, hipStream_t stream) {
    static int grid = 0;
    if (grid == 0) {
        if (n_in != 21 || in_sizes[0] != T * D || out_size != T * D || ws_size < WS_END) {
            fprintf(stderr, "kernel_launch: shape/workspace mismatch: n_in %d in0 %d out %d ws %zu (need %zu); nothing launched\n", n_in, n_in > 0 ? in_sizes[0] : -1, out_size, ws_size, (size_t)WS_END); grid = -1; return; }
        int dev = 0, cus = 0, per_cu = 0;
        if (hipGetDevice(&dev) != hipSuccess || hipDeviceGetAttribute(&cus, hipDeviceAttributeMultiprocessorCount, dev) != hipSuccess) { grid = -1; return; }
        if (hipFuncSetAttribute((const void*)mega_fwd, hipFuncAttributeMaxDynamicSharedMemorySize, LDS_BYTES) != hipSuccess) { fprintf(stderr, "kernel_launch: hipFuncSetAttribute failed\n"); grid = -1; return; }
        if (hipOccupancyMaxActiveBlocksPerMultiprocessor(&per_cu, (const void*)mega_fwd, NTHR, LDS_BYTES) != hipSuccess || per_cu < 1) {
            fprintf(stderr, "kernel_launch: occupancy query reports %d workgroups per CU\n", per_cu); per_cu = 1; }
        (void)hipGetLastError();
        grid = cus;
        fprintf(stderr, "kernel_launch: grid %d (cus %d, occupancy %d/CU), ws %zu\n", grid, cus, per_cu, ws_size);
    }
    if (grid < 0) return;
    if (hipMemsetAsync((char*)d_ws + WS_CTL, 0, CTL_ZERO_BYTES, stream) != hipSuccess) { fprintf(stderr, "kernel_launch: memset failed\n"); return; }
    Args a{};
    for (int i = 0; i < 21; ++i) a.in[i] = (const float*)d_in[i];
    a.out = (float*)d_out; a.ws = (unsigned char*)d_ws; a.grid = grid;
    if (MK_N_LAUNCHES == 1) {
        a.ph_lo = 0; a.ph_hi = NPHASE;
        hipLaunchKernelGGL(mega_fwd, dim3(grid), dim3(NTHR), LDS_BYTES, stream, a);
    } else {
        for (int p = 0; p < NPHASE; ++p) { const int reps = ((PROBE_MASK >> p) & 1) ? 2 : 1;
            for (int rp = 0; rp < reps; ++rp) { a.ph_lo = p; a.ph_hi = p + 1; a.dup = (p == 11) ? (reps - 1 - rp) : rp; hipLaunchKernelGGL(mega_fwd, dim3(grid), dim3(NTHR), LDS_BYTES, stream, a); } }
    }
    const hipError_t le = hipPeekAtLastError();
    if (le != hipSuccess) fprintf(stderr, "kernel_launch: launch failed: %s\n", hipGetErrorName(le));
}
```

```cpp
#include <hip/hip_runtime.h>
#include <cstdio>
#include <cstdint>

#ifndef MK_N_LAUNCHES
#define MK_N_LAUNCHES 1
#endif

#ifndef MOE_FP8
#define MOE_FP8 1
#endif
#ifndef PROBE_MASK
#define PROBE_MASK 0x0
#endif
#define GAS __attribute__((address_space(1)))
#define LAS __attribute__((address_space(3)))

__device__ __forceinline__ int lane_id_now() { int l_; asm volatile("v_mbcnt_lo_u32_b32 %0, -1, 0\n\tv_mbcnt_hi_u32_b32 %0, -1, %0" : "=v"(l_)); return l_; }
namespace pg8 {
#define PG8_LAS __attribute__((address_space(3)))
typedef unsigned short bf16_t;
typedef short bf16x8 __attribute__((ext_vector_type(8)));
typedef float f32x4 __attribute__((ext_vector_type(4)));
typedef unsigned u32x4 __attribute__((ext_vector_type(4)));
typedef unsigned u32x2 __attribute__((ext_vector_type(2)));
typedef int i32x8 __attribute__((ext_vector_type(8)));
typedef int i32x4 __attribute__((ext_vector_type(4)));
constexpr int BM = 256, BK = 64, HALF = 128, HTB = HALF * BK * 2, STAGE_BYTES = 8 * HTB, NXCD = 8, WGM = 4;

__host__ __device__ __forceinline__ int lds_byte(int r, int c) { const int st = (r >> 4) * 2 + (c >> 5), rr = r & 15, cc = c & 31, ob = rr * 64 + cc * 2; return st * 1024 + (ob ^ (((ob >> 9) & 1) << 5)); }
__host__ __device__ __forceinline__ void stage_rc(int b, int& R, int& C) { const int st = b / 1024, sb = b % 1024, swz = sb ^ (((sb >> 9) & 1) << 5); R = (st >> 1) * 16 + swz / 64; C = (st & 1) * 32 + (swz % 64) / 2; }
__host__ __device__ __forceinline__ int perm32(int rho) { const int n = rho >> 4, i = rho & 15; return 8 * (i >> 2) + 4 * n + (i & 3); }

struct Unit { int pm, pn, aux; };

__device__ __forceinline__ void tile_of(int L, int nM, int nN, int& pm, int& pn) {
    const int nwg = nM * nN; int wgid = L;
    { const int q = nwg / NXCD, r = nwg % NXCD, xcd = wgid % NXCD, off = wgid / NXCD; wgid = (xcd < r ? xcd * (q + 1) : r * (q + 1) + (xcd - r) * q) + off; }
    const int nig = WGM * nN, gid = wgid / nig, fm = gid * WGM, gsz = (nM - fm) < WGM ? (nM - fm) : WGM;
    pm = fm + ((wgid % nig) % gsz); pn = (wgid % nig) / gsz;
}

__device__ __forceinline__ const char* uni(const char* p) { const unsigned long long v = (unsigned long long)p; const unsigned lo = __builtin_amdgcn_readfirstlane((unsigned)v), hi = __builtin_amdgcn_readfirstlane((unsigned)(v >> 32)); return (const char*)(((unsigned long long)hi << 32) | lo); }
__device__ __forceinline__ unsigned cvt_pk_bf16(float lo, float hi) { unsigned r; asm volatile("v_cvt_pk_bf16_f32 %0, %1, %2" : "=v"(r) : "v"(lo), "v"(hi)); return r; }

template <int K, class Epi, class Sched, bool ALIGN_EPI, bool SP2, bool FP8 = false>
__device__ __forceinline__ void gemm_phase(PG8_LAS unsigned char* lds, const Sched& S, const Epi& E, const int wid) {
    const int lane = lane_id_now(), tid = wid * 64 + lane, wr = wid >> 2, wc = wid & 3, fr = lane & 15, fq = lane >> 4;
    constexpr int nt = K / BK;
    unsigned voffA, voffB;
    { int R, C; stage_rc(tid * 16, R, C); const int Rb = Epi::PERM ? ((R & ~31) + perm32(R & 31)) : R;
        voffA = (unsigned)(R * K + C) * 2u; voffB = (unsigned)(Rb * K + C) * 2u; }
    constexpr size_t pstep = (size_t)64 * K * 2;
    constexpr size_t kstep = (size_t)(BK * 2);
    constexpr size_t hstep = (size_t)HALF * K * 2;
    constexpr size_t tstep = 2 * hstep;
    const unsigned ldsw = (unsigned)wid * 1024u;
    const int aoff = lds_byte(wr * 64 + fr, fq * 8), boff = lds_byte(wc * 32 + fr, fq * 8);
#define PG8_SA(b, h) (((b) * 2 + (h)) * HTB)
#define PG8_SB(b, h) ((4 + (b) * 2 + (h)) * HTB)
#define PG8_STAGE(bufoff, gbase, voff) do { _Pragma("unroll") for (int _i = 0; _i < 2; ++_i) \
        __builtin_amdgcn_global_load_lds((const unsigned*)((const char*)(gbase) + _i * pstep + (voff)), (PG8_LAS unsigned*)(lds + (bufoff) + ldsw + _i * 8192), 16, 0, 0); } while (0)
#define PG8_LDA(dst, b, h) do { _Pragma("unroll") for (int m = 0; m < 4; ++m) _Pragma("unroll") for (int k = 0; k < 2; ++k) dst[m][k] = *(const PG8_LAS bf16x8*)(lds + PG8_SA(b, h) + aoff + m * 2048 + k * 1024); } while (0)
#define PG8_LDB(dst, b, h) do { _Pragma("unroll") for (int n = 0; n < 2; ++n) _Pragma("unroll") for (int k = 0; k < 2; ++k) dst[n][k] = *(const PG8_LAS bf16x8*)(lds + PG8_SB(b, h) + boff + n * 2048 + k * 1024); } while (0)
#define PG8_MMA(ai, bj, At, Bt) do { __builtin_amdgcn_s_setprio(1); _Pragma("unroll") for (int m = 0; m < 4; ++m) _Pragma("unroll") for (int n = 0; n < 2; ++n) { \
        if constexpr (FP8) {   \
            const i32x8 fa_ = __builtin_bit_cast(i32x8, __builtin_shufflevector(At[m][0], At[m][1], 0, 1, 2, 3, 4, 5, 6, 7, 8, 9, 10, 11, 12, 13, 14, 15)); \
            const i32x8 fb_ = __builtin_bit_cast(i32x8, __builtin_shufflevector(Bt[n][0], Bt[n][1], 0, 1, 2, 3, 4, 5, 6, 7, 8, 9, 10, 11, 12, 13, 14, 15)); \
            acc[ai][bj][m][n] = __builtin_amdgcn_mfma_scale_f32_16x16x128_f8f6f4(fb_, fa_, acc[ai][bj][m][n], 0, 0, 0, 0x7f7f7f7f, 0, 0x7f7f7f7f); \
        } else { _Pragma("unroll") for (int k = 0; k < 2; ++k) acc[ai][bj][m][n] = __builtin_amdgcn_mfma_f32_16x16x32_bf16(Bt[n][k], At[m][k], acc[ai][bj][m][n], 0, 0, 0); } } \
        __builtin_amdgcn_s_setprio(0); } while (0)
#define PG8_WAIT_V(n) asm volatile("s_waitcnt vmcnt(" #n ")" ::: "memory")
#define PG8_WAIT_L(n) asm volatile("s_waitcnt lgkmcnt(" #n ")" ::: "memory")
#define PG8_BAR __builtin_amdgcn_s_barrier()
#define PG8_SCHED __builtin_amdgcn_sched_barrier(0)
    Unit cur, nxt; int ui = 0;
    if (!S.next(0, cur)) return;
    f32x4 acc[2][2][4][2];
#pragma unroll
    for (int a = 0; a < 2; ++a)
#pragma unroll
        for (int b = 0; b < 2; ++b)
#pragma unroll
            for (int m = 0; m < 4; ++m)
#pragma unroll
                for (int n = 0; n < 2; ++n) acc[a][b][m][n] = (f32x4){0.f, 0.f, 0.f, 0.f};
    bf16x8 At[4][2], B0[2][2], B1[2][2];
    const char* cA = (const char*)S.pa(cur) + (size_t)cur.pm * tstep; const char* cB = (const char*)S.pb(cur) + (size_t)cur.pn * tstep;
    if constexpr (SP2) {
        PG8_STAGE(PG8_SB(0, 0), cB, voffB); PG8_STAGE(PG8_SB(0, 1), cB + hstep, voffB); PG8_STAGE(PG8_SA(0, 0), cA, voffA); PG8_STAGE(PG8_SA(0, 1), cA + hstep, voffA);
        if (wr == 1) PG8_BAR;
        PG8_WAIT_V(2); PG8_BAR;
        PG8_STAGE(PG8_SB(1, 0), cB + kstep, voffB); PG8_STAGE(PG8_SA(1, 0), cA + kstep, voffA); PG8_STAGE(PG8_SB(1, 1), cB + hstep + kstep, voffB);
        PG8_WAIT_V(6); PG8_BAR;
    } else {
        PG8_STAGE(PG8_SB(0, 0), cB, voffB); PG8_STAGE(PG8_SA(0, 0), cA, voffA); PG8_STAGE(PG8_SB(0, 1), cB + hstep, voffB); PG8_STAGE(PG8_SA(0, 1), cA + hstep, voffA);
        if (wr == 1) PG8_BAR;
        PG8_WAIT_V(4); PG8_BAR;
        PG8_STAGE(PG8_SB(1, 0), cB + kstep, voffB); PG8_STAGE(PG8_SA(1, 0), cA + kstep, voffA); PG8_STAGE(PG8_SB(1, 1), cB + hstep + kstep, voffB);
        PG8_WAIT_V(6); PG8_BAR;
    }
    for (;;) {
        const bool has_next = S.next(ui + 1, nxt);
        if (!has_next) S.last_unit(wid, lane);
        const char* nA = has_next ? (const char*)S.pa(nxt) + (size_t)nxt.pm * tstep : cA; const char* nB = has_next ? (const char*)S.pb(nxt) + (size_t)nxt.pn * tstep : cB;
#pragma unroll 1
        for (int t = 0; t < nt; t += 2) {
            const bool last = (t == nt - 2);
            const char* a1 = uni(cA + (size_t)(t + 1) * kstep);
            const char* a2 = uni(last ? nA : cA + (size_t)(t + 2) * kstep); const char* b2 = uni(last ? nB : cB + (size_t)(t + 2) * kstep);
            const char* a3 = a2 + kstep; const char* b3 = b2 + kstep;
            if constexpr (SP2) {
            PG8_LDB(B0, 0, 0); PG8_LDB(B1, 0, 1); PG8_SCHED; PG8_LDA(At, 0, 0); PG8_STAGE(PG8_SA(1, 1), a1 + hstep, voffA);
            PG8_WAIT_V(8); PG8_WAIT_L(0); PG8_BAR; PG8_MMA(0, 0, At, B0); PG8_MMA(0, 1, At, B1); PG8_BAR; PG8_SCHED;
            PG8_LDA(At, 0, 1); PG8_STAGE(PG8_SB(0, 0), b2, voffB); PG8_STAGE(PG8_SB(0, 1), b2 + hstep, voffB); PG8_STAGE(PG8_SA(0, 0), a2, voffA);
            PG8_WAIT_V(8); PG8_WAIT_L(0); PG8_BAR; PG8_MMA(1, 0, At, B0); PG8_MMA(1, 1, At, B1); PG8_BAR; PG8_SCHED;
            PG8_LDB(B0, 1, 0); PG8_LDB(B1, 1, 1); PG8_SCHED; PG8_LDA(At, 1, 0); PG8_STAGE(PG8_SA(0, 1), a2 + hstep, voffA);
            PG8_WAIT_V(8); PG8_WAIT_L(0); PG8_BAR; PG8_MMA(0, 0, At, B0); PG8_MMA(0, 1, At, B1); PG8_BAR; PG8_SCHED;
            PG8_LDA(At, 1, 1); PG8_STAGE(PG8_SB(1, 0), b3, voffB); PG8_STAGE(PG8_SB(1, 1), b3 + hstep, voffB); PG8_STAGE(PG8_SA(1, 0), a3, voffA);
            PG8_WAIT_V(8); PG8_WAIT_L(0); PG8_BAR; PG8_MMA(1, 0, At, B0); PG8_MMA(1, 1, At, B1); PG8_BAR; PG8_SCHED;
            } else {
            PG8_LDB(B0, 0, 0); PG8_SCHED; PG8_LDA(At, 0, 0); PG8_STAGE(PG8_SA(1, 1), a1 + hstep, voffA);
            PG8_WAIT_L(8); PG8_BAR; PG8_WAIT_L(0); PG8_MMA(0, 0, At, B0); PG8_BAR; PG8_SCHED;
            PG8_LDB(B1, 0, 1); PG8_STAGE(PG8_SB(0, 0), b2, voffB);
            PG8_BAR; PG8_WAIT_L(0); PG8_MMA(0, 1, At, B1); PG8_BAR;
            PG8_LDA(At, 0, 1); PG8_STAGE(PG8_SA(0, 0), a2, voffA);
            PG8_BAR; PG8_WAIT_L(0); PG8_MMA(1, 0, At, B0); PG8_BAR; PG8_SCHED;
            PG8_STAGE(PG8_SB(0, 1), b2 + hstep, voffB);
            PG8_WAIT_V(6); PG8_BAR; PG8_MMA(1, 1, At, B1); PG8_BAR;
            PG8_LDB(B0, 1, 0); PG8_SCHED; PG8_LDA(At, 1, 0); PG8_STAGE(PG8_SA(0, 1), a2 + hstep, voffA);
            PG8_WAIT_L(8); PG8_BAR; PG8_WAIT_L(0); PG8_MMA(0, 0, At, B0); PG8_BAR; PG8_SCHED;
            PG8_LDB(B1, 1, 1); PG8_STAGE(PG8_SB(1, 0), b3, voffB);
            PG8_BAR; PG8_WAIT_L(0); PG8_MMA(0, 1, At, B1); PG8_BAR;
            PG8_LDA(At, 1, 1); PG8_STAGE(PG8_SA(1, 0), a3, voffA);
            PG8_BAR; PG8_WAIT_L(0); PG8_MMA(1, 0, At, B0); PG8_BAR; PG8_SCHED;
            PG8_STAGE(PG8_SB(1, 1), b3 + hstep, voffB);
            PG8_WAIT_V(6); PG8_BAR; PG8_MMA(1, 1, At, B1); PG8_BAR;
            }
        }
        if constexpr (ALIGN_EPI) { if (wr == 0) PG8_BAR; }
        const bool keep = E(acc, cur, wr, wc, fr, fq);
        if (!has_next) break;
        if (!keep) {
#pragma unroll
            for (int a = 0; a < 2; ++a)
#pragma unroll
                for (int b = 0; b < 2; ++b)
#pragma unroll
                    for (int m = 0; m < 4; ++m)
#pragma unroll
                        for (int n = 0; n < 2; ++n) acc[a][b][m][n] = (f32x4){0.f, 0.f, 0.f, 0.f};
        }
        cur = nxt; cA = nA; cB = nB; ++ui;
        if constexpr (ALIGN_EPI) { if (wr == 1) PG8_BAR; }
    }
    PG8_WAIT_V(0);
    if constexpr (!ALIGN_EPI) { if (wr == 0) PG8_BAR; }
    PG8_BAR;
#undef PG8_SA
#undef PG8_SB
#undef PG8_STAGE
#undef PG8_LDA
#undef PG8_LDB
#undef PG8_MMA
#undef PG8_WAIT_V
#undef PG8_WAIT_L
#undef PG8_BAR
#undef PG8_SCHED
}
}

typedef unsigned short bf16;
typedef unsigned v4u __attribute__((ext_vector_type(4)));
typedef unsigned v2u __attribute__((ext_vector_type(2)));
typedef float f32x4 __attribute__((ext_vector_type(4)));
typedef float f32x16 __attribute__((ext_vector_type(16)));
typedef short bf16x8 __attribute__((ext_vector_type(8)));
typedef GAS unsigned gu32;

constexpr int NWAVES = 8, NTHR = 512;
constexpr int BATCH = 8, SEQ = 2048, T = BATCH * SEQ, D = 1024;
constexpr int NH = 4, DK = 128, DV = 256, CH = 128, NCH = SEQ / CH;
constexpr int QK = NH * DK, VD = NH * DV;
constexpr int RANK = 16;
constexpr int NE = 16, CAP = 256, DFF = 2816, EROWS = BATCH * CAP;
constexpr int DIN = 8224, DINP = 8448;
constexpr float EPS = 1e-6f;
constexpr int NPHASE = 12;

constexpr size_t MiB = 1u << 20;
constexpr size_t WS_CTL = 0, CTL_ZERO_BYTES = 1 * MiB;
constexpr size_t WS_WBR = 1 * MiB, WS_WBG = 3 * MiB, WS_WOUT = 5 * MiB;
constexpr size_t WS_AL = 7 * MiB, WS_BE = 8 * MiB;
constexpr size_t WS_AFF = 9 * MiB;
constexpr size_t WS_RK = 10 * MiB;
constexpr size_t WS_GATEV = 11 * MiB;
constexpr size_t WS_GA = 12 * MiB;
constexpr size_t WS_WGU = 16 * MiB;
constexpr size_t WS_R0 = 192 * MiB;
constexpr size_t WS_R1 = 256 * MiB;
constexpr size_t WS_R2 = 320 * MiB;
constexpr size_t WS_R3 = 384 * MiB;
constexpr size_t WS_R4 = 512 * MiB;
constexpr size_t WS_QKR = WS_R0, WS_RO = WS_R0, WS_Y = WS_R0;
constexpr size_t WS_V = WS_R1, WS_MERGED = WS_R1, WS_H2 = WS_R1 + 32 * MiB;
constexpr size_t WS_G = WS_R2, WS_XG = WS_R2;
constexpr size_t WS_QT = WS_R3, WS_KT = WS_R3 + 64 * MiB, WS_ACT = WS_R3;
constexpr size_t WS_XN = WS_R4, WS_WIN = WS_R4 + 32 * MiB, WS_RT = WS_R4;
constexpr size_t WS_WDN = MOE_FP8 ? 104 * MiB : 560 * MiB;
constexpr size_t WS_END = 648 * MiB;
static_assert(MOE_FP8 ? (WS_WGU + (size_t)NE * 2 * DFF * D <= WS_WDN && WS_WDN + (size_t)NE * D * DFF <= WS_R0) : (WS_ACT + (size_t)NE * EROWS * DFF * 2 <= WS_WDN && WS_WDN + (size_t)NE * D * DFF * 2 <= WS_END), "WDN placement");
static_assert(WS_WIN + (size_t)DINP * D * 2 <= WS_R4 + 128 * MiB, "WIN fits");
constexpr int CW_CONVQ = 64;
constexpr int CW_DONE = 128;
constexpr int CW_BAR = 4096;

constexpr int RING_BYTES = 131072;
constexpr int LDSCTL_OFF = RING_BYTES, MISC_OFF = LDSCTL_OFF + 320;
constexpr int LDS_BYTES = 147456;

#define RLX_AGENT __ATOMIC_RELAXED, __HIP_MEMORY_SCOPE_AGENT
#define LDS_WAIT() asm volatile("s_waitcnt lgkmcnt(0)" ::: "memory")
#define VM_WAIT() asm volatile("s_waitcnt vmcnt(0)" ::: "memory")
__device__ __forceinline__ unsigned f2bf(float f) { unsigned u = __builtin_bit_cast(unsigned, f); return (u + 0x7fffu + ((u >> 16) & 1u)) >> 16; }
__device__ __forceinline__ unsigned pk2(float lo, float hi) { unsigned r; asm("v_cvt_pk_bf16_f32 %0, %1, %2" : "=v"(r) : "v"(lo), "v"(hi)); return r; }
__device__ __forceinline__ float bf2f(unsigned u16) { return __builtin_bit_cast(float, u16 << 16); }
__device__ __forceinline__ float bflo(unsigned w) { return __builtin_bit_cast(float, w << 16); }
__device__ __forceinline__ float bfhi(unsigned w) { return __builtin_bit_cast(float, w & 0xffff0000u); }
__device__ __forceinline__ unsigned pk4_fp8(float a, float b, float c, float d) {
    a = __builtin_amdgcn_fmed3f(a, -448.f, 448.f); b = __builtin_amdgcn_fmed3f(b, -448.f, 448.f); c = __builtin_amdgcn_fmed3f(c, -448.f, 448.f); d = __builtin_amdgcn_fmed3f(d, -448.f, 448.f);
    int w = 0; w = __builtin_amdgcn_cvt_pk_fp8_f32(a, b, w, false); w = __builtin_amdgcn_cvt_pk_fp8_f32(c, d, w, true); return (unsigned)w; }
constexpr float SC_W = 256.f, SC_H = 8.f, SC_A = 4.f;
__device__ __forceinline__ float fast_sigmoid(float x) { return __builtin_amdgcn_rcpf(1.0f + __builtin_amdgcn_exp2f(-1.4426950408889634f * x)); }
__device__ __forceinline__ float fast_silu(float x) { return x * fast_sigmoid(x); }
__device__ __forceinline__ float log_sigmoid(float z) { return fminf(z, 0.f) - log1pf(expf(-fabsf(z))); }
__device__ __forceinline__ float fexp(float x) { return __builtin_amdgcn_exp2f(1.4426950408889634f * x); }
__device__ __forceinline__ float fast_log_sigmoid(float z) { return fminf(z, 0.f) - 0.6931471805599453f * __builtin_amdgcn_logf(1.0f + fexp(-fabsf(z))); }

#define XB_TMO      128
#define XB_XCNT(j)  (256  + 64 * (j))
#define XB_XSUB(j)  (1280 + 64 * (j))
#define XB_XGEN(j)  (2304 + 64 * (j))
#define XB_TOP      3328
#define XB_TOPGEN   3392
#define XCD_BAR_WORDS 3456
#define XB_SPIN_CAP (1u << 20)
__device__ __forceinline__ unsigned xb_ld(unsigned* p)              { return __hip_atomic_load(p, __ATOMIC_RELAXED, __HIP_MEMORY_SCOPE_AGENT); }
__device__ __forceinline__ unsigned xb_add(unsigned* p, unsigned v) { return __hip_atomic_fetch_add(p, v, __ATOMIC_RELAXED, __HIP_MEMORY_SCOPE_AGENT); }
__device__ __forceinline__ unsigned xb_xcc_id() { return (unsigned)__builtin_amdgcn_s_getreg((3 << 11) | 20) & 0xFu; }
#define XB_SPIN(cond, bar) do { unsigned _sp = 0; while (cond) { __builtin_amdgcn_s_sleep(1); \
    if ((++_sp & 255u) == 0u) { if (xb_ld(&(bar)[XB_TMO])) break; if (_sp > XB_SPIN_CAP) { atomicAdd(&(bar)[XB_TMO], 1u); break; } } } } while (0)
struct XcdBarrier { unsigned* bar; unsigned x; volatile LAS unsigned* st; unsigned G; int wave; };
__device__ __forceinline__ XcdBarrier xcd_barrier_post(unsigned* bar, volatile LAS unsigned* st, int wave) {
    XcdBarrier b; b.bar = bar; b.x = xb_xcc_id(); b.st = st; b.G = 0; b.wave = wave;
    if (wave == 0 && lane_id_now() == 0) (void)xb_add(&bar[XB_XCNT(b.x)], 1u);
    return b;
}
__device__ __forceinline__ void xcd_barrier_complete(unsigned* bar, unsigned x, unsigned G_, unsigned& nloc, unsigned& nx) {
    const unsigned G = (unsigned)__builtin_amdgcn_readfirstlane(G_);
    unsigned sum, cnt, mine, sp = 0u;
    for (;;) {
        sum = 0u; cnt = 0u; mine = 0u;
#pragma unroll
        for (unsigned j = 0; j < 16; ++j) { const unsigned c = xb_ld(&bar[XB_XCNT(j)]); sum += c; cnt += (c > 0u) ? 1u : 0u; mine = (j == x) ? c : mine; }
        if ((unsigned)__builtin_amdgcn_readfirstlane(sum) == G) break;
        __builtin_amdgcn_s_sleep(1);
        if ((++sp & 255u) == 0u) { if (xb_ld(&bar[XB_TMO])) break; if (sp > XB_SPIN_CAP) { atomicAdd(&bar[XB_TMO], 1u); break; } }
    }
    nloc = mine > 0u ? mine : 1u; nx = cnt > 0u ? cnt : 1u;
}
__device__ __forceinline__ void xcd_barrier(const XcdBarrier& b, const unsigned G) {
    asm volatile("s_waitcnt vmcnt(0)" ::: "memory");
    __syncthreads();
    if (b.wave == 0 && lane_id_now() == 0) {
        unsigned* bar = b.bar;
        __builtin_amdgcn_s_waitcnt(0);
        unsigned nloc = b.st[0], nx = b.st[1];
        if (nloc == 0u) { xcd_barrier_complete(bar, b.x, G, nloc, nx); b.st[0] = nloc; b.st[1] = nx; }
        const unsigned old = xb_add(&bar[XB_XSUB(b.x)], 1u);
        const unsigned gen = old / nloc;
        if (old + 1u == (gen + 1u) * nloc) {
            __builtin_amdgcn_fence(__ATOMIC_RELEASE, "agent");
            asm volatile("s_waitcnt vmcnt(0)" ::: "memory");
            const unsigned og = xb_add(&bar[XB_TOP], 1u);
            const unsigned tg = og / nx;
            if (og + 1u == (tg + 1u) * nx) xb_add(&bar[XB_TOPGEN], 1u);
            else XB_SPIN(xb_ld(&bar[XB_TOPGEN]) == tg, bar);
            __builtin_amdgcn_fence(__ATOMIC_ACQUIRE, "agent");
            xb_add(&bar[XB_XGEN(b.x)], 1u);
            asm volatile("s_waitcnt vmcnt(0)" ::: "memory");
        } else {
            XB_SPIN(xb_ld(&bar[XB_XGEN(b.x)]) == gen, bar);
            __builtin_amdgcn_fence(__ATOMIC_ACQUIRE, "agent");
            asm volatile("s_waitcnt vmcnt(0)" ::: "memory");
        }
    }
    __syncthreads();
}

struct Args { const float* in[21]; float* out; unsigned char* ws; int ph_lo, ph_hi, dup, grid; };
struct Frame {
    LAS unsigned char* lds;
    int tid, lane, wave, vcu, G;
    float* out; unsigned char* ws;
};
#define IN_X 0
#define IN_POS 1
#define IN_NORM_MIX 2
#define IN_W_IN 3
#define IN_RDF 4
#define IN_RDB 5
#define IN_RET_NORM 6
#define IN_GWF 7
#define IN_GBF 8
#define IN_GWB 9
#define IN_GBB 10
#define IN_GLA_NORM 11
#define IN_WBR 12
#define IN_WBG 13
#define IN_WOUT 14
#define IN_NORM_FFN 15
#define IN_W_ROUTER 16
#define IN_W_GATE 17
#define IN_W_UP 18
#define IN_W_DOWN 19
#define IN_NORM_FINAL 20

__device__ __forceinline__ float wave_sum(float v) {
#pragma unroll
    for (int o = 1; o < 64; o <<= 1) v += __shfl_xor(v, o);
    return v;
}

struct TrItem { const float* W; bf16* WT; int N, K, kb, n0, drow0, f8; };
__device__ __forceinline__ void tr_load(const TrItem& t, int lane, f32x4 (&v)[8]) {
    const int k0 = 64 * t.kb, c4 = lane & 7, r8 = lane >> 3;
#pragma unroll
    for (int i = 0; i < 8; ++i) v[i] = __builtin_nontemporal_load((const f32x4*)(t.W + (size_t)(k0 + 8 * i + r8) * t.N + t.n0 + 4 * c4));
}
__device__ __forceinline__ void tr_finish(const TrItem& t, int lane, const f32x4 (&v)[8], LAS float* scr) {
    const int k0 = 64 * t.kb, c4 = lane & 7, r8 = lane >> 3;
#pragma unroll
    for (int i = 0; i < 8; ++i) { LAS float* d = scr + (8 * i + r8) * 33 + 4 * c4; d[0] = v[i].x; d[1] = v[i].y; d[2] = v[i].z; d[3] = v[i].w; }
    LDS_WAIT(); asm volatile("" ::: "memory");
    const int c = lane & 7;
    if (t.f8) {
#pragma unroll
        for (int j = 0; j < 4; ++j) { const int n = (lane >> 3) + 8 * j; const LAS float* s = scr + (8 * c) * 33 + n;
            v2u o; o.x = pk4_fp8(s[0 * 33] * SC_W, s[1 * 33] * SC_W, s[2 * 33] * SC_W, s[3 * 33] * SC_W); o.y = pk4_fp8(s[4 * 33] * SC_W, s[5 * 33] * SC_W, s[6 * 33] * SC_W, s[7 * 33] * SC_W);
            *(GAS v2u*)((unsigned char*)t.WT + (size_t)(t.drow0 + n) * t.K + k0 + 8 * c) = o; }
    } else {
#pragma unroll
        for (int j = 0; j < 4; ++j) { const int n = (lane >> 3) + 8 * j; const LAS float* s = scr + (8 * c) * 33 + n;
            v4u o; o.x = pk2(s[0 * 33], s[1 * 33]); o.y = pk2(s[2 * 33], s[3 * 33]); o.z = pk2(s[4 * 33], s[5 * 33]); o.w = pk2(s[6 * 33], s[7 * 33]);
            *(GAS v4u*)(t.WT + (size_t)(t.drow0 + n) * t.K + k0 + 8 * c) = o; }
    }
    LDS_WAIT(); asm volatile("" ::: "memory");
}
__device__ __forceinline__ void rms_row_store(int lane, const f32x4 (&v)[4], const f32x4 (&g)[4], bf16* orow) {
    float s = 0.f;
#pragma unroll
    for (int j = 0; j < 4; ++j) s += (v[j].x * v[j].x + v[j].y * v[j].y) + (v[j].z * v[j].z + v[j].w * v[j].w);
    const float rstd = 1.f / sqrtf(wave_sum(s) * (1.f / D) + EPS);
    GAS v2u* o8 = (GAS v2u*)orow + lane;
#pragma unroll
    for (int j = 0; j < 4; ++j) { v2u o; o.x = pk2(v[j].x * rstd * g[j].x, v[j].y * rstd * g[j].y); o.y = pk2(v[j].z * rstd * g[j].z, v[j].w * rstd * g[j].w); o8[64 * j] = o; }
}

constexpr int P0_I_IN = (D / 64) * (DIN / 32);
constexpr int P0_I_SQ = (D / 64) * (D / 32);
constexpr int P0_NSTATIC = P0_I_IN + 3 * P0_I_SQ;
constexpr int QY_PER = (D / 128) * (DFF / 32);
constexpr int Q_GU1 = NE * QY_PER;
constexpr int Q_GU = 2 * Q_GU1, Q_DN = NE * QY_PER, Q_N = Q_GU + Q_DN;
constexpr int NG1 = 176;
constexpr int P1_ROUNDS = (64 * 33 + NG1 - 1) / NG1, P1_LATE = 64 * 33 - NG1 * (P1_ROUNDS - 1), P1_EARLY = NG1 - P1_LATE;
constexpr int Q_P1 = MOE_FP8 ? Q_N : Q_GU;
constexpr int QCH = 6;
template <int LIST> __device__ __forceinline__ void cv_decode(const Frame& F, const Args& A, int it, TrItem& t) {
    if (LIST == 0) {
        int r = it;
        if (r < P0_I_IN) { const int nblk = DIN / 32, kb = r / nblk, nb = r % nblk, n0 = 32 * nb;
            t.f8 = 0; t.W = A.in[IN_W_IN]; t.WT = (bf16*)(F.ws + WS_WIN); t.N = DIN; t.K = D; t.kb = kb; t.n0 = n0; t.drow0 = n0 < 6144 ? n0 : (n0 < 6176 ? 8192 + (n0 - 6144) : n0 - 32); return; }
        r -= P0_I_IN;
        { const int w = r / P0_I_SQ, q = r % P0_I_SQ;
          t.W = w == 0 ? A.in[IN_WBR] : (w == 1 ? A.in[IN_WBG] : A.in[IN_WOUT]); t.WT = (bf16*)(F.ws + (w == 0 ? WS_WBR : (w == 1 ? WS_WBG : WS_WOUT)));
          t.f8 = 0; t.N = D; t.K = D; t.kb = q / 32; t.n0 = 32 * (q % 32); t.drow0 = t.n0; }
    }
}
static_assert(MOE_FP8 == 1, "the expert-weight stream writes fp8 rows");
struct YItem { const float* src; unsigned char* dst; int N, K; };
__device__ __forceinline__ void y_decode(const Frame& F, const Args& A, int it, YItem& t) {
    if (it < Q_GU) { const int up = it / Q_GU1, q = it % Q_GU1, e = q / QY_PER, q2 = q % QY_PER, k0 = 128 * (q2 / (DFF / 32)), n0 = 32 * (q2 % (DFF / 32));
        const int drow0 = 256 * (n0 >> 7) + (n0 & 127) + (up ? 128 : 0);
        t.src = (up ? A.in[IN_W_UP] : A.in[IN_W_GATE]) + (size_t)e * D * DFF + (size_t)k0 * DFF + n0; t.N = DFF;
        t.dst = F.ws + WS_WGU + (size_t)e * (2 * DFF) * D + (size_t)drow0 * D + k0; t.K = D; return; }
    { const int r = it - Q_GU, e = r / QY_PER, q = r % QY_PER, k0 = 128 * (q / (D / 32)), n0 = 32 * (q % (D / 32));
      t.src = A.in[IN_W_DOWN] + (size_t)e * DFF * D + (size_t)k0 * D + n0; t.N = D;
      t.dst = F.ws + WS_WDN + (size_t)e * D * DFF + (size_t)n0 * DFF + k0; t.K = DFF; }
}
__device__ __forceinline__ void y_ld(const Frame& F, const Args& A, int it, f32x4 (&v)[16]) {
    YItem t; y_decode(F, A, it, t); const int r8 = F.lane >> 3, c4 = F.lane & 7;
    const float* p = t.src + (size_t)(16 * r8) * t.N + 4 * c4;
#pragma unroll
    for (int i = 0; i < 16; ++i) v[i] = __builtin_nontemporal_load((const f32x4*)(p + (size_t)i * t.N));
}
__device__ __forceinline__ void y_fin(const Frame& F, const Args& A, int it, const f32x4 (&v)[16]) {
    YItem t; y_decode(F, A, it, t); const int r8 = F.lane >> 3, c4 = F.lane & 7;
    unsigned char* d = t.dst + (size_t)(4 * c4) * t.K + 16 * r8;
#pragma unroll
    for (int x = 0; x < 4; ++x) { v4u o;
        o.x = pk4_fp8(v[0][x] * SC_W, v[1][x] * SC_W, v[2][x] * SC_W, v[3][x] * SC_W);     o.y = pk4_fp8(v[4][x] * SC_W, v[5][x] * SC_W, v[6][x] * SC_W, v[7][x] * SC_W);
        o.z = pk4_fp8(v[8][x] * SC_W, v[9][x] * SC_W, v[10][x] * SC_W, v[11][x] * SC_W);   o.w = pk4_fp8(v[12][x] * SC_W, v[13][x] * SC_W, v[14][x] * SC_W, v[15][x] * SC_W);
        *(GAS v4u*)(d + (size_t)x * t.K) = o; }
}
__device__ __forceinline__ void y_range(Frame& F, const Args& A, int first, int last, int stride) {
    if (first >= last) return;
    const int n = (last - first + stride - 1) / stride;
#define Y_IDX(k) (first + ((k) < n ? (k) : n - 1) * stride)
    f32x4 va[16], vb[16], vc[16];
    y_ld(F, A, Y_IDX(0), va); y_ld(F, A, Y_IDX(1), vb);
    for (int i = 0; i < n; i += 3) {
        y_ld(F, A, Y_IDX(i + 2), vc); y_fin(F, A, Y_IDX(i), va);
        y_ld(F, A, Y_IDX(i + 3), va); y_fin(F, A, Y_IDX(i + 1), vb);
        y_ld(F, A, Y_IDX(i + 4), vb); y_fin(F, A, Y_IDX(i + 2), vc);
    }
#undef Y_IDX
}
template <int LIST> __device__ __forceinline__ void cv_ld(const Frame& F, const Args& A, int it, f32x4 (&v)[8]) { TrItem t; cv_decode<LIST>(F, A, it, t); tr_load(t, F.lane, v); }
template <int LIST> __device__ __forceinline__ void cv_fin(const Frame& F, const Args& A, int it, const f32x4 (&v)[8], LAS float* scr) { TrItem t; cv_decode<LIST>(F, A, it, t); tr_finish(t, F.lane, v, scr); }
template <int LIST> __device__ __forceinline__ void cv_range(Frame& F, const Args& A, int first, int last, int stride, LAS float* scr) {
    if (first >= last) return;
    const int n = (last - first + stride - 1) / stride;
#define CV_IDX(k) (first + ((k) < n ? (k) : n - 1) * stride)
    f32x4 va[8], vb[8], vc[8];
    cv_ld<LIST>(F, A, CV_IDX(0), va); cv_ld<LIST>(F, A, CV_IDX(1), vb);
    for (int i = 0; i < n; i += 3) {
        cv_ld<LIST>(F, A, CV_IDX(i + 2), vc); cv_fin<LIST>(F, A, CV_IDX(i), va, scr);
        cv_ld<LIST>(F, A, CV_IDX(i + 3), va); cv_fin<LIST>(F, A, CV_IDX(i + 1), vb, scr);
        cv_ld<LIST>(F, A, CV_IDX(i + 4), vb); cv_fin<LIST>(F, A, CV_IDX(i + 2), vc, scr);
    }
#undef CV_IDX
}
__device__ __forceinline__ void p0_prologue(Frame& F, const Args& A) {
    LAS float* scr = (LAS float*)(F.lds + F.wave * 16384);
    const int gw = F.vcu * NWAVES + F.wave, NGW = F.G * NWAVES;
    bf16* WIN = (bf16*)(F.ws + WS_WIN);
    cv_range<0>(F, A, gw, P0_NSTATIC, NGW, scr);
    if (F.G != 256) y_range(F, A, gw, Q_N, NGW);
    for (int i = gw * 64 + F.lane; i < (DINP - DIN) * D / 8; i += NGW * 64) *(GAS v4u*)(WIN + (size_t)DIN * D + (size_t)i * 8) = (v4u){0u, 0u, 0u, 0u};
    bf16* XN = (bf16*)(F.ws + WS_XN);
    { f32x4 gm[4];
#pragma unroll
      for (int j = 0; j < 4; ++j) gm[j] = *((const GAS f32x4*)A.in[IN_NORM_MIX] + F.lane + 64 * j);
      for (int m0 = gw; m0 < T; m0 += 2 * NGW) {
          f32x4 va[4], vb[4]; const int m1 = m0 + NGW;
#pragma unroll
          for (int j = 0; j < 4; ++j) { va[j] = *((const GAS f32x4*)(A.in[IN_X] + (size_t)m0 * D) + F.lane + 64 * j); vb[j] = *((const GAS f32x4*)(A.in[IN_X] + (size_t)(m1 < T ? m1 : m0) * D) + F.lane + 64 * j); }
          rms_row_store(F.lane, va, gm, XN + (size_t)m0 * D);
          if (m1 < T) rms_row_store(F.lane, vb, gm, XN + (size_t)m1 * D);
      } }
}
struct P1Pull { unsigned d, it0; };
__device__ __forceinline__ P1Pull p1_pull_issue(gu32* ctr, gu32* done, int lane) {
    P1Pull r;
    if (lane == 0) { r.d = __hip_atomic_load(done, RLX_AGENT); const unsigned q_ = (unsigned)QCH; asm volatile("global_atomic_add %0, %1, %2, off sc0" : "=v"(r.it0) : "v"(ctr), "v"(q_) : "memory"); }
    return r;
}
__device__ __forceinline__ void p1_stream(Frame& F, const Args& A) {
    static_assert(QCH == 6, "the loop body below is written for chunks of six");
    gu32* ctr = (gu32*)(F.ws + WS_CTL) + CW_CONVQ; gu32* done = (gu32*)(F.ws + WS_CTL) + CW_DONE;
#define QI(base, k) ((base) + (k) < Q_P1 ? (base) + (k) : Q_P1 - 1)
    unsigned d0 = 0, t0 = 0;
    if (F.lane == 0) { d0 = __hip_atomic_load(done, RLX_AGENT); if (d0 <= (unsigned)P1_EARLY) t0 = __hip_atomic_fetch_add(ctr, (unsigned)QCH, RLX_AGENT); }
    d0 = __builtin_amdgcn_readfirstlane(d0); t0 = __builtin_amdgcn_readfirstlane(t0);
    if (d0 > (unsigned)P1_EARLY || t0 >= (unsigned)Q_P1) return;
    int i0 = (int)t0; bool stopping = false;
    f32x4 va[16], vb[16], vc[16];
    y_ld(F, A, QI(i0, 0), va); y_ld(F, A, QI(i0, 1), vb);
    for (;;) {
        P1Pull pr; if (!stopping) pr = p1_pull_issue(ctr, done, F.lane);
        y_ld(F, A, QI(i0, 2), vc); y_fin(F, A, QI(i0, 0), va);
        y_ld(F, A, QI(i0, 3), va); y_fin(F, A, QI(i0, 1), vb);
        y_ld(F, A, QI(i0, 4), vb); y_fin(F, A, QI(i0, 2), vc);
        y_ld(F, A, QI(i0, 5), vc); y_fin(F, A, QI(i0, 3), va);
        __builtin_amdgcn_sched_barrier(0);
        int it1 = -1; bool stop_next = true;
        if (!stopping) { const unsigned d = __builtin_amdgcn_readfirstlane(pr.d), t = __builtin_amdgcn_readfirstlane(pr.it0); it1 = t < (unsigned)Q_P1 ? (int)t : -1; stop_next = d > (unsigned)P1_EARLY; }
        const int i1 = it1 >= 0 ? it1 : i0;
        y_ld(F, A, QI(i1, 0), va); y_fin(F, A, QI(i0, 4), vb);
        y_ld(F, A, QI(i1, 1), vb); y_fin(F, A, QI(i0, 5), vc);
        if (it1 < 0) break;
        i0 = i1; stopping = stop_next;
    }
#undef QI
}

struct SchedPlain {
    int nM, nN, G, c; const bf16* A; const bf16* Bt; gu32* lastctr;
    __device__ __forceinline__ void last_unit(int wid, int lane) const { if (lastctr && wid == 0 && lane == 0) __hip_atomic_fetch_add(lastctr, 1u, RLX_AGENT); }
    __device__ __forceinline__ bool next(int i, pg8::Unit& u) const {
        const long L = (long)i * G + c; if (L >= (long)nM * nN) return false;
        pg8::tile_of((int)L, nM, nN, u.pm, u.pn); u.aux = 0; return true; }
    __device__ __forceinline__ const bf16* pa(const pg8::Unit&) const { return A; }
    __device__ __forceinline__ const bf16* pb(const pg8::Unit&) const { return Bt; }
};
struct SchedBranch {
    int G, c; const bf16* A0; const bf16* A1; const bf16* B0; const bf16* B1;
    __device__ __forceinline__ void last_unit(int, int) const {}
    __device__ __forceinline__ bool next(int i, pg8::Unit& u) const {
        const long L = (long)(i >> 1) * G + c; if (L >= 64 * 4) return false;
        pg8::tile_of((int)L, 64, 4, u.pm, u.pn); u.aux = i & 1; return true; }
    __device__ __forceinline__ const bf16* pa(const pg8::Unit& u) const { return u.aux ? A1 : A0; }
    __device__ __forceinline__ const bf16* pb(const pg8::Unit& u) const { return u.aux ? B1 : B0; }
};
struct SchedMoe {
    int NP, G, c; const bf16* A; const bf16* Bt;
    __device__ __forceinline__ void last_unit(int, int) const {}
    __device__ __forceinline__ bool next(int i, pg8::Unit& u) const {
        const int nwg = NE * 8 * NP; const long L = (long)i * G + c; if (L >= nwg) return false;
        int wgid = (int)L; { const int q = nwg / 8, xcd = wgid % 8, off = wgid / 8; wgid = xcd * q + off; }
        const int e = wgid / (8 * NP), rem = wgid % (8 * NP), pnl = rem / 8, pml = rem % 8;
        u.pm = e * 8 + pml; u.pn = e * NP + pnl; u.aux = pnl; return true; }
    __device__ __forceinline__ const bf16* pa(const pg8::Unit&) const { return A; }
    __device__ __forceinline__ const bf16* pb(const pg8::Unit&) const { return Bt; }
};

struct EpiInProj {
    static constexpr bool PERM = true;
    bf16* QKR; bf16* V; bf16* Gt; bf16* SG; float* GA;
    __device__ __forceinline__ bool operator()(pg8::f32x4 (&acc)[2][2][4][2], const pg8::Unit& u, int wr, int wc, int fr, int fq) const {
        const int pn = u.pn; const int row0 = u.pm * 256 + wr * 64 + fr;
        if (pn == 32) {
            if (wc == 0) {
#pragma unroll
                for (int ai = 0; ai < 2; ++ai)
#pragma unroll
                    for (int m = 0; m < 4; ++m) { float* rp = GA + (size_t)(row0 + ai * 128 + m * 16) * 32 + 8 * fq;
                        *(pg8::f32x4*)(rp) = acc[ai][0][m][0]; *(pg8::f32x4*)(rp + 4) = acc[ai][0][m][1]; }
            }
            return false;
        }
        bf16* base; int ldc, colt, act;
        if (pn < 2)       { base = QKR;                         ldc = QK; colt = pn * 256;        act = 0; }
        else if (pn < 4)  { base = QKR + (size_t)1 * T * QK;    ldc = QK; colt = (pn - 2) * 256;  act = 0; }
        else if (pn < 8)  { base = V;                           ldc = VD; colt = (pn - 4) * 256;  act = 0; }
        else if (pn < 12) { base = Gt;                          ldc = VD; colt = (pn - 8) * 256;  act = 1; }
        else if (pn < 14) { base = QKR + (size_t)2 * T * QK;    ldc = QK; colt = (pn - 12) * 256; act = 0; }
        else if (pn < 16) { base = QKR + (size_t)3 * T * QK;    ldc = QK; colt = (pn - 14) * 256; act = 0; }
        else if (pn < 20) { base = V + (size_t)T * VD;          ldc = VD; colt = (pn - 16) * 256; act = 0; }
        else if (pn < 24) { base = Gt + (size_t)T * VD;         ldc = VD; colt = (pn - 20) * 256; act = 1; }
        else if (pn < 28) { base = SG;                          ldc = VD; colt = (pn - 24) * 256; act = 2; }
        else              { base = SG + (size_t)T * VD;         ldc = VD; colt = (pn - 28) * 256; act = 2; }
        const int col0 = colt + wc * 32 + 8 * fq;
#pragma unroll
        for (int ai = 0; ai < 2; ++ai)
#pragma unroll
            for (int m = 0; m < 4; ++m) { bf16* rowp = base + (size_t)(row0 + ai * 128 + m * 16) * ldc + col0;
#pragma unroll
                for (int bj = 0; bj < 2; ++bj) { pg8::f32x4 v0 = acc[ai][bj][m][0], v1 = acc[ai][bj][m][1];
                    if (act == 1) {
#pragma unroll
                        for (int x = 0; x < 4; ++x) { v0[x] = fast_silu(v0[x]); v1[x] = fast_silu(v1[x]); } }
                    else if (act == 2) {
#pragma unroll
                        for (int x = 0; x < 4; ++x) { v0[x] = fast_sigmoid(v0[x]); v1[x] = fast_sigmoid(v1[x]); } }
                    pg8::u32x4 w; w.x = pg8::cvt_pk_bf16(v0[0], v0[1]); w.y = pg8::cvt_pk_bf16(v0[2], v0[3]); w.z = pg8::cvt_pk_bf16(v1[0], v1[1]); w.w = pg8::cvt_pk_bf16(v1[2], v1[3]);
                    *(pg8::u32x4*)(rowp + bj * 128) = w; } }
        return false;
    }
};
struct EpiBranch {
    static constexpr bool PERM = true;
    const bf16* SG; bf16* O;
    __device__ __forceinline__ bool operator()(pg8::f32x4 (&acc)[2][2][4][2], const pg8::Unit& u, int wr, int wc, int fr, int fq) const {
        const int row0 = u.pm * 256 + wr * 64 + fr, col0 = u.pn * 256 + wc * 32 + 8 * fq;
        if (u.aux == 0) {
#pragma unroll
            for (int ai = 0; ai < 2; ++ai) {
                pg8::u32x4 g1[4][2], g0[4][2];
#pragma unroll
                for (int m = 0; m < 4; ++m)
#pragma unroll
                    for (int bj = 0; bj < 2; ++bj) { const size_t off = (size_t)(row0 + ai * 128 + m * 16) * VD + col0 + bj * 128;
                        g1[m][bj] = *(const pg8::u32x4*)(SG + (size_t)T * VD + off); g0[m][bj] = *(const pg8::u32x4*)(SG + off); }
#pragma unroll
                for (int m = 0; m < 4; ++m)
#pragma unroll
                    for (int bj = 0; bj < 2; ++bj) { const pg8::u32x4 a1 = g1[m][bj], a0 = g0[m][bj];
                        pg8::f32x4 s1a = {bflo(a1.x), bfhi(a1.x), bflo(a1.y), bfhi(a1.y)}, s1b = {bflo(a1.z), bfhi(a1.z), bflo(a1.w), bfhi(a1.w)};
                        pg8::f32x4 s0a = {bflo(a0.x), bfhi(a0.x), bflo(a0.y), bfhi(a0.y)}, s0b = {bflo(a0.z), bfhi(a0.z), bflo(a0.w), bfhi(a0.w)};
#pragma unroll
                        for (int x = 0; x < 4; ++x) { acc[ai][bj][m][0][x] *= s0a[x] * __builtin_amdgcn_rcpf(s1a[x]); acc[ai][bj][m][1][x] *= s0b[x] * __builtin_amdgcn_rcpf(s1b[x]); } }
            }
            return true;
        }
#pragma unroll
        for (int ai = 0; ai < 2; ++ai) {
            pg8::u32x4 g1[4][2];
#pragma unroll
            for (int m = 0; m < 4; ++m)
#pragma unroll
                for (int bj = 0; bj < 2; ++bj) g1[m][bj] = *(const pg8::u32x4*)(SG + (size_t)T * VD + (size_t)(row0 + ai * 128 + m * 16) * VD + col0 + bj * 128);
#pragma unroll
            for (int m = 0; m < 4; ++m)
#pragma unroll
                for (int bj = 0; bj < 2; ++bj) { const pg8::u32x4 a1 = g1[m][bj];
                    pg8::f32x4 s1a = {bflo(a1.x), bfhi(a1.x), bflo(a1.y), bfhi(a1.y)}, s1b = {bflo(a1.z), bfhi(a1.z), bflo(a1.w), bfhi(a1.w)};
                    const pg8::f32x4 v0 = acc[ai][bj][m][0] * s1a, v1 = acc[ai][bj][m][1] * s1b;
                    pg8::u32x4 w; w.x = pg8::cvt_pk_bf16(v0[0], v0[1]); w.y = pg8::cvt_pk_bf16(v0[2], v0[3]); w.z = pg8::cvt_pk_bf16(v1[0], v1[1]); w.w = pg8::cvt_pk_bf16(v1[2], v1[3]);
                    *(pg8::u32x4*)(O + (size_t)(row0 + ai * 128 + m * 16) * VD + col0 + bj * 128) = w; }
        }
        return false;
    }
};
struct EpiOut {
    static constexpr bool PERM = false;
    const float* X; float* O;
    __device__ __forceinline__ bool operator()(pg8::f32x4 (&acc)[2][2][4][2], const pg8::Unit& u, int wr, int wc, int fr, int fq) const {
        const int row0 = u.pm * 256 + wr * 64 + fr, col0 = u.pn * 256 + wc * 32 + 4 * fq;
#pragma unroll
        for (int ai = 0; ai < 2; ++ai) {
            pg8::f32x4 xv[4][2][2];
#pragma unroll
            for (int m = 0; m < 4; ++m)
#pragma unroll
                for (int bj = 0; bj < 2; ++bj)
#pragma unroll
                    for (int n = 0; n < 2; ++n) xv[m][bj][n] = *(const pg8::f32x4*)(X + (size_t)(row0 + ai * 128 + m * 16) * D + col0 + bj * 128 + n * 16);
#pragma unroll
            for (int m = 0; m < 4; ++m)
#pragma unroll
                for (int bj = 0; bj < 2; ++bj)
#pragma unroll
                    for (int n = 0; n < 2; ++n) *(pg8::f32x4*)(O + (size_t)(row0 + ai * 128 + m * 16) * D + col0 + bj * 128 + n * 16) = xv[m][bj][n] + acc[ai][bj][m][n];
        }
        return false;
    }
};
struct EpiSwiGLU {
    static constexpr bool PERM = true;
    bf16* ACT;
    __device__ __forceinline__ bool operator()(pg8::f32x4 (&acc)[2][2][4][2], const pg8::Unit& u, int wr, int wc, int fr_, int fq_) const {
        const int l_ = lane_id_now(); const int fr = l_ & 15, fq = l_ >> 4; (void)fr_; (void)fq_;
        const int row0 = u.pm * 256 + wr * 64 + fr, col0 = u.aux * 128 + wc * 32 + 8 * fq;
#pragma unroll
        for (int ai = 0; ai < 2; ++ai)
#pragma unroll
            for (int m = 0; m < 4; ++m) { bf16* rowp = ACT + (size_t)(row0 + ai * 128 + m * 16) * DFF + col0;
                pg8::f32x4 v0, v1;
#if MOE_FP8
                constexpr float is = 1.f / (SC_W * SC_H);
#pragma unroll
                for (int x = 0; x < 4; ++x) { v0[x] = fast_silu(acc[ai][0][m][0][x] * is) * (acc[ai][1][m][0][x] * (is * SC_A)); v1[x] = fast_silu(acc[ai][0][m][1][x] * is) * (acc[ai][1][m][1][x] * (is * SC_A)); }
                pg8::u32x2 w; w.x = pk4_fp8(v0[0], v0[1], v0[2], v0[3]); w.y = pk4_fp8(v1[0], v1[1], v1[2], v1[3]);
                *(pg8::u32x2*)((unsigned char*)ACT + (size_t)(row0 + ai * 128 + m * 16) * DFF + col0) = w; (void)rowp; }
#else
#pragma unroll
                for (int x = 0; x < 4; ++x) { v0[x] = fast_silu(acc[ai][0][m][0][x]) * acc[ai][1][m][0][x]; v1[x] = fast_silu(acc[ai][0][m][1][x]) * acc[ai][1][m][1][x]; }
                pg8::u32x4 w; w.x = pg8::cvt_pk_bf16(v0[0], v0[1]); w.y = pg8::cvt_pk_bf16(v0[2], v0[3]); w.z = pg8::cvt_pk_bf16(v1[0], v1[1]); w.w = pg8::cvt_pk_bf16(v1[2], v1[3]);
                *(pg8::u32x4*)rowp = w; }
#endif
        return false;
    }
};
struct EpiDown {
    static constexpr bool PERM = true;
    const float* GATEV; bf16* Y;
    __device__ __forceinline__ bool operator()(pg8::f32x4 (&acc)[2][2][4][2], const pg8::Unit& u, int wr, int wc, int fr_, int fq_) const {
        const int l_ = lane_id_now(); const int fr = l_ & 15, fq = l_ >> 4; (void)fr_; (void)fq_;
        const int row0 = u.pm * 256 + wr * 64 + fr, col0 = u.aux * 256 + wc * 32 + 8 * fq;
        float gv[2][4];
#pragma unroll
        for (int ai = 0; ai < 2; ++ai)
#pragma unroll
            for (int m = 0; m < 4; ++m) gv[ai][m] = GATEV[row0 + ai * 128 + m * 16] * (MOE_FP8 ? 1.f / (SC_W * SC_A) : 1.f);
#pragma unroll
        for (int ai = 0; ai < 2; ++ai)
#pragma unroll
            for (int m = 0; m < 4; ++m) { const int row = row0 + ai * 128 + m * 16; const float g = gv[ai][m]; bf16* rowp = Y + (size_t)row * D + col0;
#pragma unroll
                for (int bj = 0; bj < 2; ++bj) { const pg8::f32x4 v0 = acc[ai][bj][m][0] * g, v1 = acc[ai][bj][m][1] * g;
                    pg8::u32x4 w; w.x = pg8::cvt_pk_bf16(v0[0], v0[1]); w.y = pg8::cvt_pk_bf16(v0[2], v0[3]); w.z = pg8::cvt_pk_bf16(v1[0], v1[1]); w.w = pg8::cvt_pk_bf16(v1[2], v1[3]);
                    *(pg8::u32x4*)(rowp + bj * 128) = w; } }
        return false;
    }
};

__device__ __forceinline__ v4u scale_chunk(v4u w, float f) { v4u o; o.x = pk2(bflo(w.x) * f, bfhi(w.x) * f); o.y = pk2(bflo(w.y) * f, bfhi(w.y) * f); o.z = pk2(bflo(w.z) * f, bfhi(w.z) * f); o.w = pk2(bflo(w.w) * f, bfhi(w.w) * f); return o; }
__device__ __forceinline__ size_t qt_index(int br, int dir, int t, int h, int d) { return ((size_t)(br * 2 + dir) * T + t) * QK + h * DK + d; }
__device__ __forceinline__ size_t ab_index(int br, int dir, int b, int h, int n, int d) { return ((((size_t)(br * 2 + dir) * BATCH + b) * NH + h) * NCH + n) * DK + d; }
__device__ __forceinline__ void p2_prep(Frame& F, const Args& A) {
    const bf16* QKR = (const bf16*)(F.ws + WS_QKR); bf16* QT = (bf16*)(F.ws + WS_QT); bf16* KT = (bf16*)(F.ws + WS_KT);
    float* AL = (float*)(F.ws + WS_AL); float* BE = (float*)(F.ws + WS_BE); const float* GA = (const float*)(F.ws + WS_GA);
    const int* POS = (const int*)(const void*)A.in[IN_POS];
    LAS float* gaL = (LAS float*)F.lds;
    LAS float* totL = (LAS float*)(F.lds + 16384);
    LAS float* refL = (LAS float*)(F.lds + 16384 + 4096);
    const float scale = 0.08838834764831845f;
    for (int item = blockIdx.x; item < 2 * BATCH * NH * NCH; item += F.G) {
        const int br = item >> 9, rem = item & 511, b = rem >> 6, h = (rem >> 4) & 3, n = rem & 15, t0 = b * SEQ + n * CH;
        if (br == 0) {
            const float lgf = log_sigmoid(A.in[IN_RDF][h]), lgb = log_sigmoid(A.in[IN_RDB][h]);
            const bf16* Q = QKR; const bf16* Kk = QKR + (size_t)T * QK;
#pragma unroll
            for (int i = 0; i < 2; ++i) {
                const int u = F.tid + 512 * i, j = u >> 3, g = u & 7, d0 = 8 * g, t = t0 + j;
                const float pos = (float)POS[t];
                const v4u q1 = *(const GAS v4u*)(Q + (size_t)t * QK + h * DK + d0), q2 = *(const GAS v4u*)(Q + (size_t)t * QK + h * DK + 64 + d0);
                const v4u k1 = *(const GAS v4u*)(Kk + (size_t)t * QK + h * DK + d0), k2 = *(const GAS v4u*)(Kk + (size_t)t * QK + h * DK + 64 + d0);
                float qa[8], qb[8], ka[8], kb[8];
#pragma unroll
                for (int x = 0; x < 8; ++x) {
                    const unsigned wq1 = q1[x >> 1], wq2 = q2[x >> 1], wk1 = k1[x >> 1], wk2 = k2[x >> 1];
                    const float a1 = (x & 1) ? bfhi(wq1) : bflo(wq1), a2 = (x & 1) ? bfhi(wq2) : bflo(wq2);
                    const float c1 = (x & 1) ? bfhi(wk1) : bflo(wk1), c2 = (x & 1) ? bfhi(wk2) : bflo(wk2);
                    const float invf = __builtin_amdgcn_exp2f(-(float)(d0 + x) * (13.287712379549449f / 64.0f));
                    const float ang = pos * invf; float rev = __builtin_amdgcn_fractf(ang * 0.15915494309189535f); const float sn = __builtin_amdgcn_sinf(rev), cs = __builtin_amdgcn_cosf(rev);
                    qa[x] = (a1 * cs - a2 * sn) * scale; qb[x] = (a2 * cs + a1 * sn) * scale;
                    ka[x] = c1 * cs - c2 * sn; kb[x] = c2 * cs + c1 * sn;
                }
                v4u o;
#define PK8(dst, arr, f) do { dst.x = pk2(arr[0] * (f), arr[1] * (f)); dst.y = pk2(arr[2] * (f), arr[3] * (f)); dst.z = pk2(arr[4] * (f), arr[5] * (f)); dst.w = pk2(arr[6] * (f), arr[7] * (f)); } while (0)
                PK8(o, qa, 1.f); *(GAS v4u*)(QT + qt_index(0, 0, t, h, d0)) = o;
                PK8(o, qb, 1.f); *(GAS v4u*)(QT + qt_index(0, 0, t, h, 64 + d0)) = o;
                PK8(o, ka, 1.f); *(GAS v4u*)(KT + qt_index(0, 0, t, h, d0)) = o;
                PK8(o, kb, 1.f); *(GAS v4u*)(KT + qt_index(0, 0, t, h, 64 + d0)) = o;
#undef PK8
            }
            if (F.tid < 128) { const int d = F.tid;
                AL[ab_index(0, 0, b, h, n, d)] = expf(63.f * lgf); BE[ab_index(0, 0, b, h, n, d)] = expf(65.f * lgf);
                AL[ab_index(0, 1, b, h, n, d)] = expf(63.f * lgb); BE[ab_index(0, 1, b, h, n, d)] = expf(65.f * lgb); }
        } else {
            __syncthreads();
            for (int i = F.tid; i < CH * 32 / 4; i += NTHR) ((LAS f32x4*)gaL)[i] = *(const GAS f32x4*)(GA + (size_t)t0 * 32 + (size_t)i * 4);
            __syncthreads();
            const int lane = F.lane, tok = lane & 15, g4 = lane >> 4, d0 = 16 * F.wave, dq = d0 + 4 * g4;
            const bf16* Q = QKR + (size_t)2 * T * QK; const bf16* Kk = QKR + (size_t)3 * T * QK;
            v2u qv[8], kv[8];
#pragma unroll
            for (int tt = 0; tt < 8; ++tt) { const size_t o = (size_t)(t0 + 16 * tt + tok) * QK + h * DK + dq; qv[tt] = *(const GAS v2u*)(Q + o); kv[tt] = *(const GAS v2u*)(Kk + o); }
#pragma unroll 1
            for (int dir = 0; dir < 2; ++dir) {
                const float* Wg = dir ? A.in[IN_GWB] : A.in[IN_GWF]; const float* Bg = dir ? A.in[IN_GBB] : A.in[IN_GBF];
                bf16x8 a1, a2;
                { float w[8];
#pragma unroll
                  for (int j = 0; j < 8; ++j) w[j] = Wg[(size_t)(8 * (g4 & 1) + j) * QK + h * DK + d0 + tok];
                  unsigned hh[8], ll[8];
#pragma unroll
                  for (int j = 0; j < 8; ++j) { hh[j] = f2bf(w[j]); ll[j] = f2bf(w[j] - bf2f(hh[j])); }
                  v4u hv, lv; hv.x = hh[0] | (hh[1] << 16); hv.y = hh[2] | (hh[3] << 16); hv.z = hh[4] | (hh[5] << 16); hv.w = hh[6] | (hh[7] << 16);
                  lv.x = ll[0] | (ll[1] << 16); lv.y = ll[2] | (ll[3] << 16); lv.z = ll[4] | (ll[5] << 16); lv.w = ll[6] | (ll[7] << 16);
                  if (g4 >= 2) lv = (v4u){0u, 0u, 0u, 0u};
                  a1 = __builtin_bit_cast(bf16x8, hv); a2 = __builtin_bit_cast(bf16x8, lv); }
                const f32x4 bias = *(const GAS f32x4*)(Bg + h * DK + dq);
                f32x4 la[8];
#pragma unroll
                for (int tt = 0; tt < 8; ++tt) {
                    const LAS float* gp = gaL + (16 * tt + tok) * 32 + dir * 16 + 8 * (g4 & 1);
                    const f32x4 g0 = *(const LAS f32x4*)gp, g1 = *(const LAS f32x4*)(gp + 4);
                    v4u gh; gh.x = pk2(g0.x, g0.y); gh.y = pk2(g0.z, g0.w); gh.z = pk2(g1.x, g1.y); gh.w = pk2(g1.z, g1.w);
                    v4u gl; gl.x = pk2(g0.x - bflo(gh.x), g0.y - bfhi(gh.x)); gl.y = pk2(g0.z - bflo(gh.y), g0.w - bfhi(gh.y));
                    gl.z = pk2(g1.x - bflo(gh.z), g1.y - bfhi(gh.z)); gl.w = pk2(g1.z - bflo(gh.w), g1.w - bfhi(gh.w));
                    const v4u z4 = {0u, 0u, 0u, 0u};
                    const bf16x8 b1 = __builtin_bit_cast(bf16x8, g4 < 2 ? gh : gl), b2 = __builtin_bit_cast(bf16x8, g4 < 2 ? gh : z4);
                    f32x4 z = {0.f, 0.f, 0.f, 0.f};
                    z = __builtin_amdgcn_mfma_f32_16x16x32_bf16(a1, b1, z, 0, 0, 0);
                    z = __builtin_amdgcn_mfma_f32_16x16x32_bf16(a2, b2, z, 0, 0, 0);
#pragma unroll
                    for (int r = 0; r < 4; ++r) la[tt][r] = fast_log_sigmoid(z[r] + bias[r]) * (1.0f / 16.0f);
                }
                f32x4 P[8]; f32x4 carry = {0.f, 0.f, 0.f, 0.f};
#pragma unroll
                for (int tt = 0; tt < 8; ++tt) {
                    f32x4 v = la[tt];
#pragma unroll
                    for (int o = 1; o < 16; o <<= 1) {
#pragma unroll
                        for (int r = 0; r < 4; ++r) { const float t = __shfl_up(v[r], o, 16); v[r] += (tok >= o) ? t : 0.f; } }
                    v += carry; P[tt] = v;
#pragma unroll
                    for (int r = 0; r < 4; ++r) carry[r] = __shfl(v[r], 15, 16);
                }
                const f32x4 all = carry;
                f32x4 ref;
                if (dir == 0) {
#pragma unroll
                    for (int r = 0; r < 4; ++r) ref[r] = __shfl(P[4][r], 0, 16);
                } else { const f32x4 s3 = all - P[3] + la[3];
#pragma unroll
                    for (int r = 0; r < 4; ++r) ref[r] = __shfl(s3[r], 15, 16); }
#pragma unroll
                for (int tt = 0; tt < 8; ++tt) {
                    const f32x4 av = dir ? (all - P[tt] + la[tt]) - ref : P[tt] - ref;
                    const int t = t0 + 16 * tt + tok;
                    const v2u qq = qv[tt], kk2 = kv[tt];
                    const float q0 = bflo(qq.x), q1 = bfhi(qq.x), q2 = bflo(qq.y), q3 = bfhi(qq.y), k0 = bflo(kk2.x), k1 = bfhi(kk2.x), k2 = bflo(kk2.y), k3 = bfhi(kk2.y);
                    const float e0 = fexp(av.x), e1 = fexp(av.y), e2 = fexp(av.z), e3 = fexp(av.w), i0 = fexp(-av.x), i1 = fexp(-av.y), i2 = fexp(-av.z), i3 = fexp(-av.w);
                    v2u oq, ok; oq.x = pk2(q0 * scale * e0, q1 * scale * e1); oq.y = pk2(q2 * scale * e2, q3 * scale * e3); ok.x = pk2(k0 * i0, k1 * i1); ok.y = pk2(k2 * i2, k3 * i3);
                    *(GAS v2u*)(QT + qt_index(1, dir, t, h, dq)) = oq; *(GAS v2u*)(KT + qt_index(1, dir, t, h, dq)) = ok;
                }
                if (tok == 0) { f32x4 al, be;
#pragma unroll
                    for (int r = 0; r < 4; ++r) { al[r] = fexp(all[r] - ref[r]); be[r] = fexp(ref[r]); }
                    *(GAS f32x4*)(AL + ab_index(1, dir, b, h, n, dq)) = al; *(GAS f32x4*)(BE + ab_index(1, dir, b, h, n, dq)) = be; }
            }
        }
    }
}

#define MFMA32(a, b, c) __builtin_amdgcn_mfma_f32_32x32x16_bf16((a), (b), (c), 0, 0, 0)
__device__ __forceinline__ bf16x8 frag_kcontig(const bf16* rowbase_k0, int hh) { return *(const GAS bf16x8*)(rowbase_k0 + 8 * hh); }
__device__ __forceinline__ bf16x8 frag_kstrided(const bf16* p, size_t pitch) {
    bf16x8 v;
#pragma unroll
    for (int jj = 0; jj < 8; ++jj) v[jj] = (short)((const GAS bf16*)p)[(size_t)jj * pitch];
    return v;
}

typedef short s16x4 __attribute__((ext_vector_type(4)));
typedef short v4i16_t __attribute__((ext_vector_type(4)));
__device__ __forceinline__ s16x4 vtr(LAS const unsigned char* p) { return __builtin_bit_cast(s16x4, __builtin_amdgcn_ds_read_tr16_b64_v4i16((LAS v4i16_t*)p)); }
__device__ __forceinline__ bf16x8 tr_frag(LAS const unsigned char* p, int pitch) { const s16x4 lo = vtr(p), hi = vtr(p + 4 * pitch); return __builtin_shufflevector(lo, hi, 0, 1, 2, 3, 4, 5, 6, 7); }
__device__ __forceinline__ bf16x8 sw_frag(LAS const unsigned char* tile, int row, int ks, int hh) { return *(const LAS bf16x8*)(tile + row * 256 + (((2 * ks + hh) ^ (row & 15)) << 4)); }

__device__ __forceinline__ size_t rt_index(int br, int dir, int b, int h, int n) { return ((((size_t)(br * 2 + dir) * BATCH + b) * NH + h) * NCH + n) * (size_t)(DV * DK); }
__device__ __forceinline__ void p3_scan(Frame& F, const Args& A) {
    const bf16* KT = (const bf16*)(F.ws + WS_KT); const bf16* V = (const bf16*)(F.ws + WS_V);
    const float* AL = (const float*)(F.ws + WS_AL); const float* BE = (const float*)(F.ws + WS_BE); bf16* RT = (bf16*)(F.ws + WS_RT);
    constexpr int TP = 320;
    LAS unsigned char* Kt = F.lds; LAS unsigned char* Vt = F.lds + 128 * TP;
    constexpr int SP = 272;
    LAS unsigned char* St = F.lds + 2 * 128 * TP;
    LAS float* ALt = (LAS float*)(F.lds + 2 * 128 * TP + 128 * SP);
    LAS float* BEt = (LAS float*)(F.lds + LDSCTL_OFF + 1024);
    static_assert(2 * 128 * TP + 128 * SP + 8192 <= 131072 && LDSCTL_OFF + 1024 + 8192 <= LDS_BYTES, "P3 LDS");
    const int lane = F.lane, r = lane & 31, hh = lane >> 5, blk = (lane >> 4) & 1, q = (lane & 15) >> 2, pp = lane & 3;
    for (int item = F.vcu; item < 256; item += F.G) {
        const int br = item >> 7, dir = (item >> 6) & 1, b = (item >> 3) & 7, h = (item >> 1) & 3, eh = item & 1;
        const int dblk = F.wave >> 1, ep = F.wave & 1;
        f32x16 S0, S1;
#pragma unroll
        for (int i = 0; i < 16; ++i) { S0[i] = 0.f; S1[i] = 0.f; }
        const float lgf3 = log_sigmoid(A.in[IN_RDF][h]), lgb3 = log_sigmoid(A.in[IN_RDB][h]);
        v4u preA[8], preB[8];
        int tidv = F.tid; asm volatile("" : "+v"(tidv));
#define P3_CH(st_) (((st_) < NCH ? (st_) : NCH - 1))
#define P3_N(st_) (dir ? NCH - 1 - P3_CH(st_) : P3_CH(st_))
#define P3_LOAD(st_, pre) do { const int t0_ = b * SEQ + P3_N(st_) * CH; _Pragma("unroll") for (int i = 0; i < 8; ++i) { const int c = tidv + 512 * i, tl = c >> 11, row = (c >> 4) & 127, ch = c & 15; \
            const bf16* src = tl ? (V + ((size_t)br * T + t0_ + row) * VD + h * DV + eh * 128 + 8 * ch) : (KT + qt_index(br, br ? dir : 0, t0_ + row, h, 8 * ch)); pre[i] = *(const GAS v4u*)src; } } while (0)
        P3_LOAD(0, preA); P3_LOAD(1, preB);
        __syncthreads();
        { const size_t abi = ab_index(br, dir, b, h, 0, 0);
          ((LAS f32x4*)ALt)[tidv] = *(const GAS f32x4*)(AL + abi + 4 * (size_t)tidv); ((LAS f32x4*)BEt)[tidv] = *(const GAS f32x4*)(BE + abi + 4 * (size_t)tidv); }
#define P3_STEP(st_, pre) do { const int n = P3_N(st_); \
            __syncthreads(); \
            _Pragma("unroll") for (int i = 0; i < 8; ++i) { const int c = tidv + 512 * i, tl = c >> 11, row = (c >> 4) & 127, ch = c & 15; \
                if (tl) *(LAS v4u*)(Vt + row * TP + ch * 16) = pre[i]; \
                else { const int cq = ch & 3, col0 = 32 * (ch >> 2) + 16 * (cq & 1) + 4 * (cq >> 1);     \
                    v4u kv_ = pre[i]; if (br == 0) kv_ = scale_chunk(kv_, fexp(dir ? (float)(row - 63) * lgb3 : (float)(64 - row) * lgf3));     \
                    v2u lo2, hi2; lo2.x = kv_.x; lo2.y = kv_.y; hi2.x = kv_.z; hi2.y = kv_.w;    \
                    *(LAS v2u*)(Kt + row * TP + col0 * 2) = lo2; *(LAS v2u*)(Kt + row * TP + (col0 + 8) * 2) = hi2; } } \
              \
            { const LAS f32x4* bp = (const LAS f32x4*)(BEt + n * 128 + 32 * dblk + 16 * hh); \
              _Pragma("unroll") for (int g = 0; g < 4; ++g) { const f32x4 be = bp[g]; \
                  _Pragma("unroll") for (int x = 0; x < 4; ++x) { S0[4 * g + x] *= be[x]; S1[4 * g + x] *= be[x]; } } } \
            { LAS unsigned char* sp = St + (ep * 64 + r) * SP + 64 * dblk + 32 * hh;                   \
              v4u o; \
              o.x = pk2(S0[0], S0[1]); o.y = pk2(S0[2], S0[3]); o.z = pk2(S0[4], S0[5]); o.w = pk2(S0[6], S0[7]);         *(LAS v4u*)(sp) = o; \
              o.x = pk2(S0[8], S0[9]); o.y = pk2(S0[10], S0[11]); o.z = pk2(S0[12], S0[13]); o.w = pk2(S0[14], S0[15]);   *(LAS v4u*)(sp + 16) = o; \
              o.x = pk2(S1[0], S1[1]); o.y = pk2(S1[2], S1[3]); o.z = pk2(S1[4], S1[5]); o.w = pk2(S1[6], S1[7]);         *(LAS v4u*)(sp + 32 * SP) = o; \
              o.x = pk2(S1[8], S1[9]); o.y = pk2(S1[10], S1[11]); o.z = pk2(S1[12], S1[13]); o.w = pk2(S1[14], S1[15]);   *(LAS v4u*)(sp + 32 * SP + 16) = o; } \
            __syncthreads(); \
            P3_LOAD((st_) + 2, pre);                            \
            { bf16* rt = RT + rt_index(br, dir, b, h, n) + (size_t)(eh * 128) * DK; \
              _Pragma("unroll") for (int i = 0; i < 4; ++i) { const int c = tidv + 512 * i, row = c >> 4, ch = c & 15; \
                  *(GAS v4u*)(rt + (size_t)row * DK + 8 * ch) = *(const LAS v4u*)(St + row * SP + ch * 16); } } \
              \
            { const LAS unsigned char* ka = Kt + (8 * hh + q) * TP + (32 * dblk + 16 * blk + 4 * pp) * 2; \
              const LAS unsigned char* vb = Vt + (8 * hh + q) * TP + (ep * 64 + 16 * blk + 4 * pp) * 2; \
              _Pragma("unroll") for (int ks = 0; ks < 8; ++ks) { \
                const bf16x8 a = tr_frag(ka + ks * 16 * TP, TP); \
                const bf16x8 b0 = tr_frag(vb + ks * 16 * TP, TP), b1 = tr_frag(vb + 64 + ks * 16 * TP, TP); \
                S0 = MFMA32(a, b0, S0); S1 = MFMA32(a, b1, S1); } } \
            { const LAS f32x4* ap = (const LAS f32x4*)(ALt + n * 128 + 32 * dblk + 16 * hh); \
              _Pragma("unroll") for (int g = 0; g < 4; ++g) { const f32x4 al = ap[g]; \
                  _Pragma("unroll") for (int x = 0; x < 4; ++x) { S0[4 * g + x] *= al[x]; S1[4 * g + x] *= al[x]; } } } \
        } while (0)
#pragma unroll 1
        for (int step = 0; step < NCH; step += 2) { P3_STEP(step, preA); P3_STEP(step + 1, preB); }
#undef P3_STEP
#undef P3_LOAD
#undef P3_N
#undef P3_CH
    }
}

__device__ __forceinline__ void p4_chunk(Frame& F, const Args& A) {
    const bf16* QT = (const bf16*)(F.ws + WS_QT); const bf16* KT = (const bf16*)(F.ws + WS_KT); const bf16* V = (const bf16*)(F.ws + WS_V);
    const bf16* RT = (const bf16*)(F.ws + WS_RT); const bf16* Gt = (const bf16*)(F.ws + WS_G); bf16* RO = (bf16*)(F.ws + WS_RO);
    constexpr int VP = 576;
    constexpr int NITEM = 2 * BATCH * NH * NCH;
    LAS unsigned char* L = F.lds;
    LAS float* ST = (LAS float*)(F.lds + LDSCTL_OFF + 1024);
    const int ib = F.wave & 3, eh = F.wave >> 2;
    v4u pre1[8];
#define P4_LOAD1(it_, dst_, i0_) do { const int br_ = (it_) >> 9, rem_ = (it_) & 511, b_ = rem_ >> 6, h_ = (rem_ >> 4) & 3, n_ = rem_ & 15, t0_ = b_ * SEQ + n_ * CH; \
        int tv_ = F.tid; asm volatile("" : "+v"(tv_)); \
        _Pragma("unroll") for (int i = 0; i < 8; ++i) { const int c = tv_ + 512 * (i + (i0_)), tl = c >> 11, row = (c >> 4) & 127, ch = c & 15; \
            dst_[i] = *(const GAS v4u*)((tl < 2 ? KT : QT) + qt_index(br_, br_ ? (tl & 1) : 0, t0_ + row, h_, 8 * ch)); } } while (0)
    int item = blockIdx.x;
    P4_LOAD1(item < NITEM ? item : 0, pre1, 0);
    for (; item < NITEM; item += F.G) {
        const int br = item >> 9, rem = item & 511, b = rem >> 6, h = (rem >> 4) & 3, n = rem & 15, t0 = b * SEQ + n * CH;
        int tidv = F.tid; asm volatile("" : "+v"(tidv));
        const float lgf4 = log_sigmoid(A.in[IN_RDF][h]), lgb4 = log_sigmoid(A.in[IN_RDB][h]);
        const int lane = tidv & 63, r = lane & 31, hh = lane >> 5, blk = (lane >> 4) & 1, q = (lane & 15) >> 2, pp = lane & 3;
        __syncthreads();
        { v4u pre2[8]; P4_LOAD1(item, pre2, 8);
#pragma unroll
          for (int i = 0; i < 8; ++i) { const int c = tidv + 512 * i, tl = c >> 11, row = (c >> 4) & 127, ch = c & 15;
              v4u w_ = pre1[i]; if (br == 0) w_ = scale_chunk(w_, fexp(tl ? (float)(row - 63) * lgb4 : (float)(64 - row) * lgf4));
              *(LAS v4u*)(L + tl * 32768 + row * 256 + ((ch ^ (row & 15)) << 4)) = w_; }
#pragma unroll
          for (int i = 0; i < 8; ++i) { const int c = tidv + 512 * (i + 8), tl = c >> 11, row = (c >> 4) & 127, ch = c & 15;
              v4u w_ = pre2[i]; if (br == 0) w_ = scale_chunk(w_, fexp(tl == 3 ? (float)(63 - row) * lgb4 : (float)(row - 64) * lgf4));
              *(LAS v4u*)(L + tl * 32768 + row * 256 + ((ch ^ (row & 15)) << 4)) = w_; } }
        __syncthreads();
        const int rowq = 32 * ib + r;
        bf16x8 qf[8], qb[8];
#pragma unroll
        for (int ks = 0; ks < 8; ++ks) { qf[ks] = sw_frag(L + 2 * 32768, rowq, ks, hh); qb[ks] = sw_frag(L + 3 * 32768, rowq, ks, hh); }
        v4u preV[8];
#pragma unroll
        for (int i = 0; i < 8; ++i) { const int c = tidv + 512 * i, row = c >> 5, ch = c & 31; preV[i] = *(const GAS v4u*)(V + ((size_t)br * T + t0 + row) * VD + h * DV + 8 * ch); }
        v2u pk[2][4];
#pragma unroll
        for (int jj2 = 0; jj2 < 2; ++jj2) {
            const int jb = 2 * eh + jj2, rowk = 32 * jb + r;
            f32x16 sf, sb;
#pragma unroll
            for (int i = 0; i < 16; ++i) { sf[i] = 0.f; sb[i] = 0.f; }
            if (jb <= ib) {
#pragma unroll
                for (int ks = 0; ks < 8; ++ks) sf = MFMA32(sw_frag(L, rowk, ks, hh), qf[ks], sf); }
            if (jb >= ib) {
#pragma unroll
                for (int ks = 0; ks < 8; ++ks) sb = MFMA32(sw_frag(L + 32768, rowk, ks, hh), qb[ks], sb); }
#pragma unroll
            for (int g = 0; g < 4; ++g) {
                const int j0 = 32 * jb + 8 * g + 4 * hh;
                float pv[4];
#pragma unroll
                for (int x = 0; x < 4; ++x) pv[x] = (j0 + x <= rowq) ? sf[4 * g + x] : sb[4 * g + x];
                pk[jj2][g].x = pk2(pv[0], pv[1]); pk[jj2][g].y = pk2(pv[2], pv[3]);
            }
        }
        __syncthreads();
#pragma unroll
        for (int jj2 = 0; jj2 < 2; ++jj2)
#pragma unroll
            for (int g = 0; g < 4; ++g) { const int jb = 2 * eh + jj2; *(LAS v2u*)(L + rowq * 256 + (((4 * jb + g) ^ (rowq & 15)) << 4) + 8 * hh) = pk[jj2][g]; }
#pragma unroll
        for (int i = 0; i < 8; ++i) { const int c = tidv + 512 * i, row = c >> 5, ch = c & 31; *(LAS v4u*)(L + 32768 + row * VP + ch * 16) = preV[i]; }
        __syncthreads();
        f32x16 acc[4];
#pragma unroll
        for (int c = 0; c < 4; ++c)
#pragma unroll
            for (int i = 0; i < 16; ++i) acc[c][i] = 0.f;
        const int ebase = eh * 128;
        { const LAS unsigned char* va = L + 32768 + (8 * hh + q) * VP + (ebase + 16 * blk + 4 * pp) * 2;
#pragma unroll
          for (int ks = 0; ks < 8; ++ks) {
            const bf16x8 pb = sw_frag(L, rowq, ks, hh);
#pragma unroll
            for (int c = 0; c < 4; ++c) acc[c] = MFMA32(tr_frag(va + ks * 16 * VP + c * 64, VP), pb, acc[c]);
            __builtin_amdgcn_sched_barrier(0);
          } }
        __syncthreads();
        v4u preR[8];
#pragma unroll
        for (int i = 0; i < 8; ++i) { const int c = tidv + 512 * i, row = c >> 4, ch = c & 15; preR[i] = *(const GAS v4u*)(RT + rt_index(br, 0, b, h, n) + (size_t)row * DK + 8 * ch); }
#pragma unroll
        for (int i = 0; i < 8; ++i) { const int c = tidv + 512 * i, row = c >> 4, ch = c & 15; *(LAS v4u*)(L + row * 256 + ((ch ^ (row & 15)) << 4)) = preR[i]; }
#pragma unroll
        for (int i = 0; i < 8; ++i) { const int c = tidv + 512 * i, row = c >> 4, ch = c & 15; preR[i] = *(const GAS v4u*)(RT + rt_index(br, 1, b, h, n) + (size_t)row * DK + 8 * ch); }
        __syncthreads();
#pragma unroll
        for (int ks = 0; ks < 8; ++ks) {
#pragma unroll
            for (int c = 0; c < 4; ++c) acc[c] = MFMA32(sw_frag(L, ebase + 32 * c + r, ks, hh), qf[ks], acc[c]);
            __builtin_amdgcn_sched_barrier(0); }
#pragma unroll
        for (int i = 0; i < 8; ++i) { const int c = tidv + 512 * i, row = c >> 4, ch = c & 15; *(LAS v4u*)(L + 65536 + row * 256 + ((ch ^ (row & 15)) << 4)) = preR[i]; }
        v4u gtv[8];
#pragma unroll
        for (int i = 0; i < 8; ++i) { const int c = tidv + 512 * i, row = c >> 5, ch = c & 31; gtv[i] = *(const GAS v4u*)(Gt + ((size_t)br * T + t0 + row) * VD + h * DV + 8 * ch); }
        __syncthreads();
#pragma unroll
        for (int ks = 0; ks < 8; ++ks) {
#pragma unroll
            for (int c = 0; c < 4; ++c) acc[c] = MFMA32(sw_frag(L + 65536, ebase + 32 * c + r, ks, hh), qb[ks], acc[c]);
            __builtin_amdgcn_sched_barrier(0); }
        float s1 = 0.f, s2 = 0.f;
#pragma unroll
        for (int c = 0; c < 4; ++c)
#pragma unroll
            for (int i = 0; i < 16; ++i) { s1 += acc[c][i]; s2 += acc[c][i] * acc[c][i]; }
        s1 += __shfl_xor(s1, 32); s2 += __shfl_xor(s2, 32);
        if (hh == 0) { ST[((ib * 2 + eh) * 32 + r) * 2] = s1; ST[((ib * 2 + eh) * 32 + r) * 2 + 1] = s2; }
        __syncthreads();
        const float o1 = ST[((ib * 2 + (eh ^ 1)) * 32 + r) * 2], o2 = ST[((ib * 2 + (eh ^ 1)) * 32 + r) * 2 + 1];
        s1 += o1; s2 += o2;
        float mu, rstd;
        if (br == 0) { mu = s1 * (1.f / DV); const float var = fmaxf(s2 * (1.f / DV) - mu * mu, 0.f); rstd = 1.f / sqrtf(var + EPS); }
        else         { mu = 0.f; rstd = 1.f / sqrtf(s2 * (1.f / DV) + EPS); }
        const float* nw = (br == 0 ? A.in[IN_RET_NORM] : A.in[IN_GLA_NORM]) + h * DV;
#pragma unroll
        for (int c = 0; c < 4; ++c)
#pragma unroll
            for (int g = 0; g < 4; ++g) {
                const int e = ebase + 32 * c + 8 * g + 4 * hh;
                const f32x4 w = *(const GAS f32x4*)(nw + e);
                v2u o; o.x = pk2((acc[c][4 * g] - mu) * rstd * w.x, (acc[c][4 * g + 1] - mu) * rstd * w.y); o.y = pk2((acc[c][4 * g + 2] - mu) * rstd * w.z, (acc[c][4 * g + 3] - mu) * rstd * w.w);
                *(LAS v2u*)(L + rowq * 512 + ((((e >> 3)) ^ (rowq & 15)) << 4) + (e & 4) * 2) = o;
            }
        __syncthreads();
        { const int nx_ = item + (int)F.G; P4_LOAD1(nx_ < NITEM ? nx_ : item, pre1, 0); }
        {
#pragma unroll
          for (int i = 0; i < 8; ++i) { const int c = tidv + 512 * i, row = c >> 5, ch = c & 31;
            const v4u y = *(const LAS v4u*)(L + row * 512 + ((ch ^ (row & 15)) << 4));
            const size_t go = ((size_t)br * T + t0 + row) * VD + h * DV + 8 * ch;
            const v4u gt = gtv[i];
            v4u o; o.x = pk2(bflo(y.x) * bflo(gt.x), bfhi(y.x) * bfhi(gt.x)); o.y = pk2(bflo(y.y) * bflo(gt.y), bfhi(y.y) * bfhi(gt.y));
            o.z = pk2(bflo(y.z) * bflo(gt.z), bfhi(y.z) * bfhi(gt.z)); o.w = pk2(bflo(y.w) * bflo(gt.w), bfhi(y.w) * bfhi(gt.w));
            *(GAS v4u*)(RO + go) = o; } }
    }
#undef P4_LOAD1
}

__device__ __forceinline__ void p7_router(Frame& F, const Args& A) {
    LAS unsigned char* WH = F.lds;
    LAS unsigned char* WL = F.lds + 32768;
    LAS float* GL = (LAS float*)(F.lds + 65536);
    LAS float* ssX = (LAS float*)(F.lds + 69632);
    LAS f32x4* lgX = (LAS f32x4*)(F.lds + 69632 + 512);
    { const float* wr = A.in[IN_W_ROUTER]; const float* gn = A.in[IN_NORM_FFN];
#pragma unroll
      for (int i = 0; i < 4; ++i) { const int x = F.tid + 512 * i, e = x & 15, kg = (x >> 4) & 3, S = x >> 6, k0 = 32 * S + 8 * kg;
          float w[8];
#pragma unroll
          for (int j = 0; j < 8; ++j) w[j] = wr[(size_t)(k0 + j) * NE + e] * gn[k0 + j];
          unsigned h[8], l[8];
#pragma unroll
          for (int j = 0; j < 8; ++j) { h[j] = f2bf(w[j]); l[j] = f2bf(w[j] - bf2f(h[j])); }
          v4u hv, lv; hv.x = h[0] | (h[1] << 16); hv.y = h[2] | (h[3] << 16); hv.z = h[4] | (h[5] << 16); hv.w = h[6] | (h[7] << 16);
          lv.x = l[0] | (l[1] << 16); lv.y = l[2] | (l[3] << 16); lv.z = l[4] | (l[5] << 16); lv.w = l[6] | (l[7] << 16);
          *(LAS v4u*)(WH + x * 16) = hv; *(LAS v4u*)(WL + x * 16) = lv; }
      if (F.tid < 256) *((LAS f32x4*)GL + F.tid) = *((const GAS f32x4*)gn + F.tid); }
    __syncthreads();
    unsigned char* H2 = (unsigned char*)(F.ws + WS_H2); float* AFF = (float*)(F.ws + WS_AFF);
    static_assert(MOE_FP8 == 1, "P7 writes fp8 rows");
    const int lane = F.lane, tok = lane & 15, kg = lane >> 4, kh = F.wave & 1;
    for (int tile0 = F.vcu * 4; tile0 < T / 16; tile0 += 4 * F.G) {
        const int m = 16 * (tile0 + (F.wave >> 1)) + tok;
        const GAS f32x4* xr = (const GAS f32x4*)(F.out + (size_t)m * D + kh * 512 + 8 * kg);
        f32x4 v[32];
#pragma unroll
        for (int s2 = 0; s2 < 16; ++s2) { v[2 * s2] = xr[8 * s2]; v[2 * s2 + 1] = xr[8 * s2 + 1]; }
        f32x4 acc = {0.f, 0.f, 0.f, 0.f}; float ss = 0.f;
        LAS const unsigned char* whp = WH + ((kh * 16 * 4 + kg) * 16 + tok) * 16; LAS const unsigned char* wlp = WL + ((kh * 16 * 4 + kg) * 16 + tok) * 16;
        asm volatile("" : "+v"(whp), "+v"(wlp));
#pragma unroll
        for (int s2 = 0; s2 < 16; ++s2) {
            const f32x4 a = v[2 * s2], c = v[2 * s2 + 1];
            ss += (a.x * a.x + a.y * a.y) + (a.z * a.z + a.w * a.w) + (c.x * c.x + c.y * c.y) + (c.z * c.z + c.w * c.w);
            v4u xh; xh.x = pk2(a.x, a.y); xh.y = pk2(a.z, a.w); xh.z = pk2(c.x, c.y); xh.w = pk2(c.z, c.w);
            v4u xl; xl.x = pk2(a.x - bflo(xh.x), a.y - bfhi(xh.x)); xl.y = pk2(a.z - bflo(xh.y), a.w - bfhi(xh.y));
            xl.z = pk2(c.x - bflo(xh.z), c.y - bfhi(xh.z)); xl.w = pk2(c.z - bflo(xh.w), c.w - bfhi(xh.w));
            const bf16x8 wh = *(const LAS bf16x8*)(whp + s2 * 1024), wl = *(const LAS bf16x8*)(wlp + s2 * 1024);
            const bf16x8 bh = __builtin_bit_cast(bf16x8, xh), bl = __builtin_bit_cast(bf16x8, xl);
            acc = __builtin_amdgcn_mfma_f32_16x16x32_bf16(wh, bh, acc, 0, 0, 0);
            acc = __builtin_amdgcn_mfma_f32_16x16x32_bf16(wh, bl, acc, 0, 0, 0);
            acc = __builtin_amdgcn_mfma_f32_16x16x32_bf16(wl, bh, acc, 0, 0, 0);
            if ((s2 & 3) == 3) __builtin_amdgcn_sched_barrier(0);
        }
        ss += __shfl_xor(ss, 16); ss += __shfl_xor(ss, 32);
        __syncthreads();
        if (kg == 0) ssX[F.wave * 16 + tok] = ss;
        lgX[F.wave * 64 + lane] = acc;
        __syncthreads();
        const float rstd = 1.f / sqrtf((ss + ssX[(F.wave ^ 1) * 16 + tok]) * (1.f / D) + EPS);
        { GAS v2u* o8 = (GAS v2u*)(H2 + (size_t)m * D + kh * 512 + 8 * kg); LAS const f32x4* gp = (LAS const f32x4*)(GL + kh * 512 + 8 * kg);
          const float sc = rstd * SC_H;
#pragma unroll
          for (int s2 = 0; s2 < 16; ++s2) { const f32x4 g0 = gp[8 * s2], g1 = gp[8 * s2 + 1]; const f32x4 a = v[2 * s2], c = v[2 * s2 + 1];
              v2u o; o.x = pk4_fp8(a.x * sc * g0.x, a.y * sc * g0.y, a.z * sc * g0.z, a.w * sc * g0.w); o.y = pk4_fp8(c.x * sc * g1.x, c.y * sc * g1.y, c.z * sc * g1.z, c.w * sc * g1.w);
              o8[4 * s2] = o; } }
        if (kh == 0) {
            const f32x4 o = lgX[(F.wave ^ 1) * 64 + lane];
            f32x4 lg; lg.x = (acc.x + o.x) * rstd; lg.y = (acc.y + o.y) * rstd; lg.z = (acc.z + o.z) * rstd; lg.w = (acc.w + o.w) * rstd;
            float mx = fmaxf(fmaxf(lg.x, lg.y), fmaxf(lg.z, lg.w)); mx = fmaxf(mx, __shfl_xor(mx, 16)); mx = fmaxf(mx, __shfl_xor(mx, 32));
            f32x4 ex; ex.x = expf(lg.x - mx); ex.y = expf(lg.y - mx); ex.z = expf(lg.z - mx); ex.w = expf(lg.w - mx);
            float sum = (ex.x + ex.y) + (ex.z + ex.w); sum += __shfl_xor(sum, 16); sum += __shfl_xor(sum, 32);
            const float inv = 1.f / sum; const int b = m >> 11, sidx = m & (SEQ - 1);
            float* ap = AFF + ((size_t)b * NE + 4 * kg) * SEQ + sidx;
            ap[0] = ex.x * inv; ap[SEQ] = ex.y * inv; ap[2 * SEQ] = ex.z * inv; ap[3 * SEQ] = ex.w * inv;
        }
    }
}

__device__ __forceinline__ int block_excl_scan(int v, LAS int* wsum, int wave, int lane, int& total) {
    int inc = v;
#pragma unroll
    for (int o = 1; o < 64; o <<= 1) { const int t = __shfl_up(inc, o); if (lane >= o) inc += t; }
    __syncthreads();
    if (lane == 63) wsum[wave] = inc;
    __syncthreads();
    int off = 0, tot = 0;
#pragma unroll
    for (int w = 0; w < NWAVES; ++w) { const int x = wsum[w]; off += (w < wave) ? x : 0; tot += x; }
    total = tot; return off + inc - v;
}
__device__ __forceinline__ void p8_topk(Frame& F, const Args& A) {
    const float* AFF = (const float*)(F.ws + WS_AFF); int* RK = (int*)(F.ws + WS_RK); float* GATEV = (float*)(F.ws + WS_GATEV);
    const bf16* H2 = (const bf16*)(F.ws + WS_H2); bf16* XG = (bf16*)(F.ws + WS_XG);
    LAS int* sel = (LAS int*)(F.lds + 69632);
    LAS int* cntL = (LAS int*)(F.lds + 69632 + 1024);
    LAS int* wsum = (LAS int*)(F.lds + 69632 + 2048);
    for (int item2 = blockIdx.x; item2 < 2 * BATCH * NE; item2 += F.G) {
        const int item = item2 & (BATCH * NE - 1), half = item2 >> 7;
        const int b = item >> 4, e = item & 15;
        __syncthreads();
        if (F.tid < 64) cntL[F.tid] = 0;
        const v4u k4 = *(const GAS v4u*)(AFF + ((size_t)b * NE + e) * SEQ + 4 * F.tid);
        const unsigned kk[4] = {k4.x, k4.y, k4.z, k4.w};
        __syncthreads();
        unsigned lo = 0u, hi = 0x3F800001u; int it = 0;
        while (hi - lo > 1u) {
            const unsigned q = (hi - lo + 3u) >> 2;
            const unsigned m1 = lo + q, m2 = (lo + 2u * q < hi) ? lo + 2u * q : hi, m3 = (lo + 3u * q < hi) ? lo + 3u * q : hi;
            const int c1 = __popcll(__ballot(k4.x >= m1)) + __popcll(__ballot(k4.y >= m1)) + __popcll(__ballot(k4.z >= m1)) + __popcll(__ballot(k4.w >= m1));
            const int c2 = __popcll(__ballot(k4.x >= m2)) + __popcll(__ballot(k4.y >= m2)) + __popcll(__ballot(k4.z >= m2)) + __popcll(__ballot(k4.w >= m2));
            const int c3 = __popcll(__ballot(k4.x >= m3)) + __popcll(__ballot(k4.y >= m3)) + __popcll(__ballot(k4.z >= m3)) + __popcll(__ballot(k4.w >= m3));
            if (F.lane < 3) __hip_atomic_fetch_add(&cntL[3 * it + F.lane], F.lane == 0 ? c1 : (F.lane == 1 ? c2 : c3), __ATOMIC_RELAXED, __HIP_MEMORY_SCOPE_WORKGROUP);
            __syncthreads();
            const int t1 = cntL[3 * it], t2 = cntL[3 * it + 1], t3 = cntL[3 * it + 2];
            if (t3 >= CAP) lo = m3; else if (t2 >= CAP) { lo = m2; hi = m3; } else if (t1 >= CAP) { lo = m1; hi = m2; } else hi = m1;
            ++it;
        }
        const unsigned thr = lo;
        int ngt_tot, eq_tot;
        const int ngt = (k4.x > thr) + (k4.y > thr) + (k4.z > thr) + (k4.w > thr);
        const int neq = (k4.x == thr) + (k4.y == thr) + (k4.z == thr) + (k4.w == thr);
        (void)block_excl_scan(ngt, wsum, F.wave, F.lane, ngt_tot);
        int eqpre = block_excl_scan(neq, wsum, F.wave, F.lane, eq_tot);
        const int need = CAP - ngt_tot;
        int f[4]; int nsel = 0;
#pragma unroll
        for (int x = 0; x < 4; ++x) { const unsigned k = kk[x]; const bool iseq = (k == thr); f[x] = (k > thr) || (iseq && eqpre < need); eqpre += iseq ? 1 : 0; nsel += f[x]; }
        int sel_tot; int slot = block_excl_scan(nsel, wsum, F.wave, F.lane, sel_tot);
#pragma unroll
        for (int x = 0; x < 4; ++x) { const int i = 4 * F.tid + x;
            if (half == 0) RK[((size_t)b * SEQ + i) * NE + e] = f[x] ? slot : 0x7fffffff;
            if (f[x]) { sel[slot] = i; if (half == 0) GATEV[(size_t)e * EROWS + b * CAP + slot] = __builtin_bit_cast(float, kk[x]); ++slot; } }
        __syncthreads();
        constexpr int RB = MOE_FP8 ? D : 2 * D, CPR = RB / 16, LCPR = MOE_FP8 ? 6 : 7;
        for (int c0 = half * (CAP / 2) * CPR; c0 < (half + 1) * (CAP / 2) * CPR; c0 += NTHR * 8) {
            v4u tmp[8];
#pragma unroll
            for (int u = 0; u < 8; ++u) { const int c = c0 + u * NTHR + F.tid, sl = c >> LCPR, ch = c & (CPR - 1); tmp[u] = *((const GAS v4u*)((const unsigned char*)H2 + ((size_t)b * SEQ + sel[sl]) * RB) + ch); }
#pragma unroll
            for (int u = 0; u < 8; ++u) { const int c = c0 + u * NTHR + F.tid, sl = c >> LCPR, ch = c & (CPR - 1); *((GAS v4u*)((unsigned char*)XG + ((size_t)e * EROWS + b * CAP + sl) * RB) + ch) = tmp[u]; }
        }
    }
    const int gw = F.vcu * NWAVES + F.wave, NGW = F.G * NWAVES;
    if (F.G == 256) {
        unsigned base = __hip_atomic_load((gu32*)(F.ws + WS_CTL) + CW_CONVQ, RLX_AGENT); base = __builtin_amdgcn_readfirstlane(base);
        if (base > (unsigned)Q_P1) base = (unsigned)Q_P1;
        if (base < (unsigned)Q_N) y_range(F, A, (int)base + gw, Q_N, NGW);
    }
}

__device__ __forceinline__ void p11_final(Frame& F, const Args& A) {
    const int gw = F.vcu * NWAVES + F.wave, NGW = F.G * NWAVES, lane = F.lane;
    const int* RK = (const int*)(F.ws + WS_RK); const bf16* Y = (const bf16*)(F.ws + WS_Y);
    f32x4 gn[4];
#pragma unroll
    for (int j = 0; j < 4; ++j) gn[j] = *((const GAS f32x4*)A.in[IN_NORM_FINAL] + lane + 64 * j);
    int rkn = (gw < T && lane < NE) ? RK[(size_t)gw * NE + lane] : 0x7fffffff;
    for (int m = gw; m < T; m += NGW) {
        GAS f32x4* xr = (GAS f32x4*)(F.out + (size_t)m * D) + lane;
        GAS f32x4* xw = A.dup ? (GAS f32x4*)((float*)(F.ws + WS_R1) + (size_t)m * D) + lane : xr;
        f32x4 v[4];
#pragma unroll
        for (int j = 0; j < 4; ++j) v[j] = xr[64 * j];
        const int rkv = rkn;
        { const int mn = m + NGW; rkn = (mn < T && lane < NE) ? RK[(size_t)mn * NE + lane] : 0x7fffffff; }
        const int b = m >> 11;
        unsigned long long mask = __ballot(rkv < CAP);
        while (mask) {
            const int e0 = __builtin_ctzll(mask); mask &= mask - 1;
            const bool two = mask != 0ull; const int e1 = two ? __builtin_ctzll(mask) : e0; if (two) mask &= mask - 1;
            const int r0 = __builtin_amdgcn_readlane(rkv, e0), r1 = __builtin_amdgcn_readlane(rkv, e1);
            const GAS v2u* y0 = (const GAS v2u*)(Y + ((size_t)e0 * EROWS + b * CAP + r0) * D) + lane;
            const GAS v2u* y1 = (const GAS v2u*)(Y + ((size_t)e1 * EROWS + b * CAP + r1) * D) + lane;
            v2u w0[4], w1[4];
#pragma unroll
            for (int j = 0; j < 4; ++j) { w0[j] = y0[64 * j]; w1[j] = y1[64 * j]; }
            const float s1 = two ? 1.f : 0.f;
#pragma unroll
            for (int j = 0; j < 4; ++j) { v[j].x += bflo(w0[j].x) + s1 * bflo(w1[j].x); v[j].y += bfhi(w0[j].x) + s1 * bfhi(w1[j].x); v[j].z += bflo(w0[j].y) + s1 * bflo(w1[j].y); v[j].w += bfhi(w0[j].y) + s1 * bfhi(w1[j].y); }
        }
        float s = 0.f;
#pragma unroll
        for (int j = 0; j < 4; ++j) s += (v[j].x * v[j].x + v[j].y * v[j].y) + (v[j].z * v[j].z + v[j].w * v[j].w);
        const float rstd = 1.f / sqrtf(wave_sum(s) * (1.f / D) + EPS);
#pragma unroll
        for (int j = 0; j < 4; ++j) xw[64 * j] = v[j] * rstd * gn[j];
    }
}

__global__ void __launch_bounds__(NTHR, 2) mega_fwd(Args args) {
    extern __shared__ __attribute__((aligned(16))) unsigned char lds[];
    Frame F;
    F.lds = (LAS unsigned char*)lds;
    F.tid = threadIdx.x; F.lane = F.tid & 63; F.wave = __builtin_amdgcn_readfirstlane(F.tid >> 6);
    F.G = args.grid; { const int bx = blockIdx.x; F.vcu = (F.G % 8 == 0) ? (bx % 8) * (F.G / 8) + bx / 8 : bx; }
    F.out = args.out; F.ws = args.ws;
    volatile LAS unsigned* MISC = (volatile LAS unsigned*)(F.lds + MISC_OFF);
    for (int u = F.tid; u < (LDS_BYTES - LDSCTL_OFF) / 4; u += NTHR) ((LAS unsigned*)(F.lds + LDSCTL_OFF))[u] = 0u;
    __syncthreads();
    const int lo = args.ph_lo, hi = args.ph_hi;
    XcdBarrier bar; bar.bar = (unsigned*)(F.ws + WS_CTL) + CW_BAR; bar.x = 0; bar.st = nullptr; bar.G = 0; bar.wave = F.wave;
    if (hi - lo > 1) bar = xcd_barrier_post((unsigned*)(F.ws + WS_CTL) + CW_BAR, MISC + 8, F.wave);
#define IN(k) (lo <= (k) && (k) < hi)
#define SEAM(k) do { if (IN(k) && IN((k) + 1)) xcd_barrier(bar, (unsigned)args.grid); } while (0)

#define REFRAME() do { F.lane = lane_id_now(); F.tid = F.wave * 64 + F.lane; } while (0)
    if (IN(0)) { REFRAME(); p0_prologue(F, args); } SEAM(0);
    if (IN(1)) {
        const bool split = (F.G == 256); const int ng = split ? NG1 : F.G;
        if ((int)blockIdx.x < ng) {
            SchedPlain S{T / 256, DINP / 256, ng, (int)blockIdx.x, (const bf16*)(F.ws + WS_XN), (const bf16*)(F.ws + WS_WIN), split ? (gu32*)(F.ws + WS_CTL) + CW_DONE : (gu32*)nullptr};
            EpiInProj E{(bf16*)(F.ws + WS_QKR), (bf16*)(F.ws + WS_V), (bf16*)(F.ws + WS_G), (bf16*)F.out, (float*)(F.ws + WS_GA)};
            pg8::gemm_phase<D, EpiInProj, SchedPlain, true, true>(F.lds, S, E, F.wave);
        }
        if (split) { REFRAME(); p1_stream(F, args); }
    } SEAM(1);
    if (IN(2)) { REFRAME(); p2_prep(F, args); } SEAM(2);
    if (IN(3)) { REFRAME(); p3_scan(F, args); } SEAM(3);
    if (IN(4)) { REFRAME(); p4_chunk(F, args); } SEAM(4);
    if (IN(5)) {
        SchedBranch S{F.G, (int)blockIdx.x, (const bf16*)(F.ws + WS_RO), (const bf16*)(F.ws + WS_RO) + (size_t)T * VD, (const bf16*)(F.ws + WS_WBR), (const bf16*)(F.ws + WS_WBG)};
        EpiBranch E{(const bf16*)F.out, (bf16*)(F.ws + WS_MERGED)};
        pg8::gemm_phase<D, EpiBranch, SchedBranch, true, true>(F.lds, S, E, F.wave);
    } SEAM(5);
    if (IN(6)) {
        SchedPlain S{T / 256, D / 256, F.G, (int)blockIdx.x, (const bf16*)(F.ws + WS_MERGED), (const bf16*)(F.ws + WS_WOUT), (gu32*)nullptr};
        EpiOut E{args.in[IN_X], F.out};
        pg8::gemm_phase<D, EpiOut, SchedPlain, true, true>(F.lds, S, E, F.wave);
    } SEAM(6);
    if (IN(7)) { REFRAME(); p7_router(F, args); } SEAM(7);
    if (IN(8)) { REFRAME(); p8_topk(F, args); } SEAM(8);
    if (IN(9)) {
        SchedMoe S{2 * DFF / 256, F.G, (int)blockIdx.x, (const bf16*)(F.ws + WS_XG), (const bf16*)(F.ws + WS_WGU)};
        EpiSwiGLU E{(bf16*)(F.ws + WS_ACT)};
        pg8::gemm_phase<(MOE_FP8 ? D / 2 : D), EpiSwiGLU, SchedMoe, true, true, MOE_FP8 != 0>(F.lds, S, E, F.wave);
    } SEAM(9);
    if (IN(10)) {
        SchedMoe S{D / 256, F.G, (int)blockIdx.x, (const bf16*)(F.ws + WS_ACT), (const bf16*)(F.ws + WS_WDN)};
        EpiDown E{(const float*)(F.ws + WS_GATEV), (bf16*)(F.ws + WS_Y)};
        pg8::gemm_phase<(MOE_FP8 ? DFF / 2 : DFF), EpiDown, SchedMoe, true, true, MOE_FP8 != 0>(F.lds, S, E, F.wave);
    } SEAM(10);
    if (IN(11)) { REFRAME(); p11_final(F, args); }
#undef REFRAME
#undef IN
#undef SEAM
}

extern "C" void kernel_launch(void* const* d_in, const int* in_sizes, int n_in, void* d_out, int out_size, void* d_ws, size_t ws_size, hipStream_t stream) {
    static int grid = 0;
    if (grid == 0) {
        if (n_in != 21 || in_sizes[0] != T * D || out_size != T * D || ws_size < WS_END) {
            fprintf(stderr, "kernel_launch: shape/workspace mismatch: n_in %d in0 %d out %d ws %zu (need %zu); nothing launched\n", n_in, n_in > 0 ? in_sizes[0] : -1, out_size, ws_size, (size_t)WS_END); grid = -1; return; }
        int dev = 0, cus = 0, per_cu = 0;
        if (hipGetDevice(&dev) != hipSuccess || hipDeviceGetAttribute(&cus, hipDeviceAttributeMultiprocessorCount, dev) != hipSuccess) { grid = -1; return; }
        if (hipFuncSetAttribute((const void*)mega_fwd, hipFuncAttributeMaxDynamicSharedMemorySize, LDS_BYTES) != hipSuccess) { fprintf(stderr, "kernel_launch: hipFuncSetAttribute failed\n"); grid = -1; return; }
        if (hipOccupancyMaxActiveBlocksPerMultiprocessor(&per_cu, (const void*)mega_fwd, NTHR, LDS_BYTES) != hipSuccess || per_cu < 1) {
            fprintf(stderr, "kernel_launch: occupancy query reports %d workgroups per CU\n", per_cu); per_cu = 1; }
        (void)hipGetLastError();
        grid = cus;
        fprintf(stderr, "kernel_launch: grid %d (cus %d, occupancy %d/CU), ws %zu\n", grid, cus, per_cu, ws_size);
    }
    if (grid < 0) return;
    if (hipMemsetAsync((char*)d_ws + WS_CTL, 0, CTL_ZERO_BYTES, stream) != hipSuccess) { fprintf(stderr, "kernel_launch: memset failed\n"); return; }
    Args a{};
    for (int i = 0; i < 21; ++i) a.in[i] = (const float*)d_in[i];
    a.out = (float*)d_out; a.ws = (unsigned char*)d_ws; a.grid = grid;
    if (MK_N_LAUNCHES == 1) {
        a.ph_lo = 0; a.ph_hi = NPHASE;
        hipLaunchKernelGGL(mega_fwd, dim3(grid), dim3(NTHR), LDS_BYTES, stream, a);
    } else {
        for (int p = 0; p < NPHASE; ++p) { const int reps = ((PROBE_MASK >> p) & 1) ? 2 : 1;
            for (int rp = 0; rp < reps; ++rp) { a.ph_lo = p; a.ph_hi = p + 1; a.dup = (p == 11) ? (reps - 1 - rp) : rp; hipLaunchKernelGGL(mega_fwd, dim3(grid), dim3(NTHR), LDS_BYTES, stream, a); } }
    }
    const hipError_t le = hipPeekAtLastError();
    if (le != hipSuccess) fprintf(stderr, "kernel_launch: launch failed: %s\n", hipGetErrorName(le));
}
```
